# Optimizing an MI355X kernel written in HIP

```python
import math
import jax, jax.numpy as jnp
from jax import lax
import numpy as np

D_MODEL = 1024
BATCH = 4
SEQ = 4096
DEPTH = 1

CHUNK = 64
HEAD_DIM = 64
A_HEADS = 8
A_WIDTH = A_HEADS * HEAD_DIM
LEFT_CHUNKS = 8
BAND = (LEFT_CHUNKS + 1) * CHUNK
MAX_REL = 128
B_HEADS = 4
B_QK_DIM = HEAD_DIM
B_V_DIM = 2 * HEAD_DIM
B_WIDTH = B_HEADS * B_V_DIM
MIX_WIDTH = A_WIDTH + B_WIDTH
IN_WIDTH = 3 * A_WIDTH + 2 * (B_HEADS * 2 * B_QK_DIM) + B_WIDTH
ROPE_THETA = 500000.0
ROPE_DIM = B_QK_DIM // 4
Q_BLOCK = 128
N_EXPERTS = 32
TOP_K = 4
D_EXPERT = D_MODEL
SWIGLU_LIMIT = 7.0
SWIGLU_ALPHA = 1.702
EPS = 1e-6
NEG_INF = -1e30
N_MOD = 6

kernel_name = "hybrid_chunked_diffattn_moe_block"


def rms_norm(x, g):
    xf = x.astype(jnp.float32)
    y = xf * lax.rsqrt(jnp.mean(xf * xf, axis=-1, keepdims=True) + EPS)
    return (y * g.astype(jnp.float32)).astype(x.dtype)


def modulate(h, shift, scale):
    return h * (1.0 + scale[:, None, :]) + shift[:, None, :]


def lambda_init_fn(layer_idx):
    return 0.8 - 0.6 * math.exp(-0.3 * layer_idx)


def partial_rope(x, cos, sin):
    half = ROPE_DIM // 2
    x1 = x[..., :half].astype(jnp.float32)
    x2 = x[..., half:ROPE_DIM].astype(jnp.float32)
    r1 = x1 * cos - x2 * sin
    r2 = x2 * cos + x1 * sin
    return jnp.concatenate([r1.astype(x.dtype), r2.astype(x.dtype), x[..., ROPE_DIM:]], axis=-1)


def chunked_relbias_attention(q, k, v, rel_table):
    b, s, h, d = q.shape
    nc = s // CHUNK
    qc = q.reshape(b, nc, CHUNK, h, d)
    pad = ((0, 0), (LEFT_CHUNKS * CHUNK, 0), (0, 0), (0, 0))
    kp = jnp.pad(k, pad).reshape(b, nc + LEFT_CHUNKS, CHUNK, h, d)
    vp = jnp.pad(v, pad).reshape(b, nc + LEFT_CHUNKS, CHUNK, h, d)
    kb = jnp.concatenate([kp[:, j:j + nc] for j in range(LEFT_CHUNKS + 1)], axis=2)
    vb = jnp.concatenate([vp[:, j:j + nc] for j in range(LEFT_CHUNKS + 1)], axis=2)
    rel = LEFT_CHUNKS * CHUNK + np.arange(CHUNK)[:, None] - np.arange(BAND)[None, :]
    rel_idx = np.clip(rel, -MAX_REL, MAX_REL) + MAX_REL
    bias = rel_table.astype(jnp.float32)[:, rel_idx]
    key_abs = (jnp.arange(nc)[:, None] - LEFT_CHUNKS) * CHUNK + jnp.arange(BAND)[None, :]
    valid = key_abs >= 0
    scores = jnp.einsum('bcihd,bcjhd->bhcij', qc, kb).astype(jnp.float32) * (d ** -0.5)
    scores = scores + bias[None, :, None, :, :]
    scores = jnp.where(valid[None, None, :, None, :], scores, NEG_INF)
    p = jax.nn.softmax(scores, axis=-1).astype(v.dtype)
    out = jnp.einsum('bhcij,bcjhd->bcihd', p, vb)
    return out.reshape(b, s, h * d)


def differential_attention(q, k, v, lam, g_subln, lambda_init):
    b, s, h = q.shape[:3]
    nb = s // Q_BLOCK
    scale = B_QK_DIM ** -0.5
    key_chunk = jnp.arange(s) // CHUNK
    qb = q.reshape(b, nb, Q_BLOCK, h, 2, B_QK_DIM).transpose(1, 0, 2, 3, 4, 5)

    def block(args):
        q_blk, blk = args
        sc = jnp.einsum('bqhcd,bkhcd->bhcqk', q_blk, k).astype(jnp.float32) * scale
        q_chunk = (blk * Q_BLOCK + jnp.arange(Q_BLOCK)) // CHUNK
        mask = key_chunk[None, :] <= q_chunk[:, None]
        sc = jnp.where(mask[None, None, None], sc, NEG_INF)
        p = jax.nn.softmax(sc, axis=-1)
        w = (p[:, :, 0] - lam * p[:, :, 1]).astype(v.dtype)
        o = jnp.einsum('bhqk,bkhd->bqhd', w, v)
        return rms_norm(o, g_subln) * (1.0 - lambda_init)

    out = lax.map(block, (qb, jnp.arange(nb)))
    return out.transpose(1, 0, 2, 3, 4).reshape(b, s, h * B_V_DIM)


def moe_ffn(h, w_router, b_router, w_gate_up, b_gate_up, w_down, b_down):
    b, s, d = h.shape
    hf = h.reshape(-1, d)
    n_tok = hf.shape[0]
    logits = (hf @ w_router).astype(jnp.float32) + b_router.astype(jnp.float32)
    top_v, top_i = lax.top_k(logits, TOP_K)
    top_w = jax.nn.softmax(top_v, axis=-1)
    flat_e = top_i.reshape(-1)
    flat_w = top_w.reshape(-1)
    order = jnp.argsort(flat_e, stable=True)
    sorted_e = flat_e[order]
    tok = order // TOP_K
    xs = hf[tok]
    group_sizes = jnp.bincount(flat_e, length=N_EXPERTS).astype(jnp.int32)
    gu = lax.ragged_dot(xs, w_gate_up, group_sizes) + b_gate_up[sorted_e]
    gate = jnp.minimum(gu[:, :D_EXPERT], SWIGLU_LIMIT)
    up = jnp.clip(gu[:, D_EXPERT:], -SWIGLU_LIMIT, SWIGLU_LIMIT)
    act = (up + 1.0) * (gate * jax.nn.sigmoid(SWIGLU_ALPHA * gate))
    y = lax.ragged_dot(act, w_down, group_sizes) + b_down[sorted_e]
    y = y * flat_w[order][:, None].astype(y.dtype)
    return jax.ops.segment_sum(y, tok, num_segments=n_tok).reshape(b, s, d)


def setup_inputs(seed: int = 0) -> dict:
    key = jax.random.key(seed)
    ks = jax.random.split(key, 24)
    f32 = jnp.float32
    nrm = lambda k, shp, sc: jax.random.normal(k, shp, f32) * sc
    x = nrm(ks[0], (BATCH, SEQ, D_MODEL), 1.0)
    c = nrm(ks[1], (BATCH, D_MODEL), 1.0)
    offset = jax.random.randint(ks[2], (BATCH, 1), 0, SEQ, dtype=jnp.int32)
    positions = (jnp.arange(SEQ, dtype=jnp.int32)[None, :] + offset).astype(jnp.int32)
    return {
        "x": x,
        "c": c,
        "positions": positions,
        "w_ada": nrm(ks[3], (DEPTH, D_MODEL, N_MOD * D_MODEL), 0.5 * D_MODEL ** -0.5),
        "b_ada": nrm(ks[4], (DEPTH, N_MOD * D_MODEL), 0.02),
        "g_mix_norm": 1.0 + nrm(ks[5], (DEPTH, D_MODEL), 0.02),
        "w_in": nrm(ks[6], (DEPTH, D_MODEL, IN_WIDTH), D_MODEL ** -0.5),
        "rel_bias": nrm(ks[7], (DEPTH, A_HEADS, 2 * MAX_REL + 1), 0.5),
        "lambda_q1": nrm(ks[8], (DEPTH, B_QK_DIM), 0.1),
        "lambda_k1": nrm(ks[9], (DEPTH, B_QK_DIM), 0.1),
        "lambda_q2": nrm(ks[10], (DEPTH, B_QK_DIM), 0.1),
        "lambda_k2": nrm(ks[11], (DEPTH, B_QK_DIM), 0.1),
        "g_subln": 1.0 + nrm(ks[12], (DEPTH, B_V_DIM), 0.02),
        "w_out": nrm(ks[13], (DEPTH, MIX_WIDTH, D_MODEL), MIX_WIDTH ** -0.5),
        "g_ffn_norm": 1.0 + nrm(ks[14], (DEPTH, D_MODEL), 0.02),
        "w_router": nrm(ks[15], (DEPTH, D_MODEL, N_EXPERTS), D_MODEL ** -0.5),
        "b_router": nrm(ks[16], (DEPTH, N_EXPERTS), 0.01),
        "w_gate_up": nrm(ks[17], (DEPTH, N_EXPERTS, D_MODEL, 2 * D_EXPERT), D_MODEL ** -0.5),
        "b_gate_up": nrm(ks[18], (DEPTH, N_EXPERTS, 2 * D_EXPERT), 0.02),
        "w_down": nrm(ks[19], (DEPTH, N_EXPERTS, D_EXPERT, D_MODEL), D_EXPERT ** -0.5),
        "b_down": nrm(ks[20], (DEPTH, N_EXPERTS, D_MODEL), 0.02),
        "g_final": 1.0 + nrm(ks[21], (D_MODEL,), 0.02),
    }


def reference(x, c, positions, w_ada, b_ada, g_mix_norm, w_in, rel_bias, lambda_q1, lambda_k1,
              lambda_q2, lambda_k2, g_subln, w_out, g_ffn_norm, w_router, b_router, w_gate_up,
              b_gate_up, w_down, b_down, g_final):
    b, s, _ = x.shape
    inv_freq = ROPE_THETA ** (-jnp.arange(0, ROPE_DIM, 2, dtype=jnp.float32) / ROPE_DIM)
    ang = positions.astype(jnp.float32)[..., None] * inv_freq
    cos = jnp.cos(ang)[:, :, None, None, :]
    sin = jnp.sin(ang)[:, :, None, None, :]
    c_act = jax.nn.silu(c)
    qk_b = B_HEADS * 2 * B_QK_DIM
    for l in range(DEPTH):
        mod = c_act @ w_ada[l] + b_ada[l]
        sh_m, sc_m, gt_m, sh_f, sc_f, gt_f = jnp.split(mod, N_MOD, axis=-1)
        lambda_init = lambda_init_fn(l)

        h = modulate(rms_norm(x, g_mix_norm[l]), sh_m, sc_m)
        proj = h @ w_in[l]
        q_a, k_a, v_a, q_b, k_b, v_b = jnp.split(
            proj, np.cumsum([A_WIDTH, A_WIDTH, A_WIDTH, qk_b, qk_b]).tolist(), axis=-1)
        shp_a = (b, s, A_HEADS, HEAD_DIM)
        o_a = chunked_relbias_attention(q_a.reshape(shp_a), k_a.reshape(shp_a),
                                        v_a.reshape(shp_a), rel_bias[l])
        shp_b = (b, s, B_HEADS, 2, B_QK_DIM)
        q_b = partial_rope(q_b.reshape(shp_b), cos, sin)
        k_b = partial_rope(k_b.reshape(shp_b), cos, sin)
        lam = (jnp.exp(jnp.sum(lambda_q1[l].astype(jnp.float32) * lambda_k1[l].astype(jnp.float32)))
               - jnp.exp(jnp.sum(lambda_q2[l].astype(jnp.float32) * lambda_k2[l].astype(jnp.float32)))
               + lambda_init)
        o_b = differential_attention(q_b, k_b, v_b.reshape(b, s, B_HEADS, B_V_DIM), lam,
                                     g_subln[l], lambda_init)
        mix = jnp.concatenate([o_a, o_b], axis=-1) @ w_out[l]
        x = x + gt_m[:, None, :] * mix

        h = modulate(rms_norm(x, g_ffn_norm[l]), sh_f, sc_f)
        ffn = moe_ffn(h, w_router[l], b_router[l], w_gate_up[l], b_gate_up[l], w_down[l], b_down[l])
        x = x + gt_f[:, None, :] * ffn
    return rms_norm(x, g_final)
```

```cpp
#include <hip/hip_runtime.h>
#include <hip/hip_bf16.h>
#include <stdint.h>
#include <math.h>

#define PROBE_DBL 0
typedef unsigned short bf16_t;
typedef float f32x4 __attribute__((ext_vector_type(4)));

constexpr int NB = 4, SEQ = 4096, DM = 1024, NTOK = NB * SEQ;
constexpr int INW = 3072;
constexpr int NE = 32, TOPK = 4;
constexpr int NSLOT_MAX = NTOK * TOPK + NE * 256;
constexpr int NGRP = 256;
constexpr float EPS = 1e-6f;
constexpr float LOG2E = 1.4426950408889634f;
constexpr float C2 = 0.125f * LOG2E;
constexpr float LAMBDA_INIT = 0.2f;
constexpr int COL_QA = 0, COL_KA = 512, COL_VA = 1024, COL_QB = 1536, COL_KB = 2048, COL_VB = 2560;
constexpr int MODP_KC = 16;

constexpr size_t MiB = 1u << 20;
constexpr size_t WS_CTL = 0, WS_MOD = 1 * MiB, WS_ROPE = 2 * MiB, WS_TOPE = 4 * MiB, WS_TOPW = 5 * MiB, WS_LRANK = 6 * MiB, WS_POS = 7 * MiB,
                 WS_HIST = 8 * MiB, WS_TOKSLOT = 9 * MiB, WS_WSLOT = 10 * MiB, WS_SA = 11 * MiB, WS_SBIN = 11 * MiB + 512 * 1024, WS_MODP = 12 * MiB, WS_WIN_T = 16 * MiB, WS_WOUT_T = 22 * MiB, WS_WGU_T = 32 * MiB,
                 WS_WD_T = 160 * MiB, WS_H = 224 * MiB, WS_PQ = 256 * MiB, WS_OC = 352 * MiB, WS_MIX = 384 * MiB, WS_X1 = 416 * MiB,
                 WS_ACT = 480 * MiB, WS_Y = 624 * MiB, WS_H8 = 768 * MiB, WS_WIN8 = 784 * MiB, WS_SBGU = 788 * MiB, WS_CMAXGU = 789 * MiB, WS_SAF = 790 * MiB, WS_SAS = 791 * MiB, WS_END = 792 * MiB;
constexpr size_t WS_WRT = WS_TOPE + 512 * 1024;
constexpr size_t WS_WD8 = WS_WD_T, WS_SBD = WS_CMAXGU;
constexpr size_t WS_H8F = WS_H, WS_WGU8 = WS_WGU_T;
constexpr size_t CTL_ZERO_BYTES = 64 * 1024;
constexpr int CW_QB = 64, CW_QA = 128, CW_QC = 192, CW_BAR = 1024, CW_CMAX_IN = 8192;

struct Ctx {
    const float *x, *c; const int* positions; const float *w_ada, *b_ada, *g_mix, *w_in, *rel_bias, *lq1, *lk1, *lq2, *lk2, *g_subln, *w_out, *g_ffn,
        *w_router, *b_router, *w_gate_up, *b_gate_up, *w_down, *b_down, *g_final;
    float* out; unsigned char* ws; int ph_lo, ph_hi;
};
typedef const __attribute__((address_space(4))) Ctx CtxK;
__device__ __forceinline__ CtxK* ctx_here() { unsigned long long v = (unsigned long long)__builtin_amdgcn_kernarg_segment_ptr(); asm volatile("" : "+s"(v)); return (CtxK*)v; }
#define WSP(T, off) ((T*)(C.ws + (off)))

__device__ __forceinline__ int hid_tid() { int t = threadIdx.x; asm volatile("" : "+v"(t)); return t; }
__device__ __forceinline__ float bf2f(bf16_t v) { return __uint_as_float(((unsigned)v) << 16); }
__device__ __forceinline__ bf16_t f2bf(float f) { unsigned u = __float_as_uint(f); return (bf16_t)((u + 0x7fffu + ((u >> 16) & 1u)) >> 16); }
__device__ __forceinline__ float wave_sum(float v) {
#pragma unroll
    for (int o = 1; o < 64; o <<= 1) v += __shfl_xor(v, o);
    return v;
}
__device__ __forceinline__ float wave_max(float v) {
#pragma unroll
    for (int o = 1; o < 64; o <<= 1) v = fmaxf(v, __shfl_xor(v, o));
    return v;
}

constexpr int RING_OFF = 0, RING_BYTES = 131072;
constexpr int LCTL_OFF = RING_BYTES;
constexpr int L_POFF = LCTL_OFF, L_TOT = L_POFF + 40 * 4, L_TILEE = L_TOT + 32 * 4, L_MISC = L_TILEE + 320 * 4, L_BARW = L_MISC + 64, L_PART = L_BARW + 64, L_SEL = L_PART + 16 * 32 * 4, L_GOFF = L_SEL + 1024, L_LG = L_GOFF + 128, L_TK = L_LG + 8 * 128 * 4, L_EP = L_TK + 8 * 32 * 4, L_END = L_EP + 2 * 3072;
constexpr int LDS_BYTES = 147456;
static_assert(L_END <= LDS_BYTES, "LDS map");
constexpr int NWAVES = 8;
#define LAS __attribute__((address_space(3)))
typedef short bf16x8 __attribute__((ext_vector_type(8)));
typedef unsigned u32x4 __attribute__((ext_vector_type(4)));
typedef float f32x2 __attribute__((ext_vector_type(2)));
typedef int i32x4 __attribute__((ext_vector_type(4)));
typedef int i32x8 __attribute__((ext_vector_type(8)));
namespace pg8 {
constexpr int BM = 256, BK = 64, HALF = 128, HTB = HALF * BK * 2  , STAGE_BYTES = 8 * HTB, NXCD = 8, WGM = 8, KD = 1024  ;
__device__ __forceinline__ int lds_byte(int r, int c) { const int st = (r >> 4) * 2 + (c >> 5), rr = r & 15, cc = c & 31, ob = rr * 64 + cc * 2; return st * 1024 + (ob ^ (((ob >> 9) & 1) << 5)); }
__device__ __forceinline__ void stage_rc(int b, int& R, int& C) { const int st = b / 1024, sb = b % 1024, swz = sb ^ (((sb >> 9) & 1) << 5); R = (st >> 1) * 16 + swz / 64; C = (st & 1) * 32 + (swz % 64) / 2; }
__device__ __forceinline__ int perm32(int rho) { const int n = rho >> 4, i = rho & 15; return 8 * (i >> 2) + 4 * n + (i & 3); }
__device__ __forceinline__ void glds16s(const char* sbase, unsigned voff, unsigned lds_dst) { unsigned keep;
    asm volatile("s_mov_b32 %0, m0\n\ts_mov_b32 m0, %3\n\ts_nop 0\n\tglobal_load_lds_dwordx4 %1, %2\n\ts_mov_b32 m0, %0" : "=&s"(keep) : "v"(voff), "s"(sbase), "s"(lds_dst) : "memory"); }
template <int IMM> __device__ __forceinline__ void glds16i(const char* sbase, unsigned voff, unsigned lds_base) { unsigned keep;
    asm volatile("s_mov_b32 %0, m0\n\ts_add_i32 m0, %3, %4\n\ts_nop 0\n\tglobal_load_lds_dwordx4 %1, %2\n\ts_mov_b32 m0, %0" : "=&s"(keep) : "v"(voff), "s"(sbase), "s"(lds_base), "n"(IMM) : "memory", "scc"); }
struct Unit { int pm, pn, e; };
__device__ __forceinline__ unsigned cvt_pk_bf16(float lo, float hi) { unsigned r; asm volatile("v_cvt_pk_bf16_f32 %0, %1, %2" : "=v"(r) : "v"(lo), "v"(hi)); return r; }

template <int KB_> struct ProbDense {
    static constexpr bool GATHER_A = false; static constexpr int KB = KB_, DT = (KB_ == 1024) ? 1 : 0;
    const char* A; const char* Bt; int nM, nN, nwg, G, c;
    __device__ __forceinline__ void init(const void* A_, const void* Bt_, int M, int N, int G_, int c_) { A = (const char*)A_; Bt = (const char*)Bt_; nM = M / BM; nN = N / BM; nwg = nM * nN; G = G_; c = c_; }
    __device__ __forceinline__ bool next(int i, Unit& u) const {
        const long L = (long)i * G + c; if (L >= nwg) return false;
        int wgid = (int)L; { const int q = nwg / NXCD, r = nwg % NXCD, xcd = wgid % NXCD, off = wgid / NXCD; wgid = (xcd < r ? xcd * (q + 1) : r * (q + 1) + (xcd - r) * q) + off; }
        const int nig = WGM * nN, gid = wgid / nig, fm = gid * WGM, gsz = (nM - fm) < WGM ? (nM - fm) : WGM;
        u.pm = fm + ((wgid % nig) % gsz); u.pn = (wgid % nig) / gsz; u.e = 0; return true;
    }
    __device__ __forceinline__ const char* a_base(const Unit& u) const { return A + (size_t)u.pm * (BM * KB); }
    __device__ __forceinline__ const char* b_base(const Unit& u) const { return Bt + (size_t)u.pn * (BM * KB); }
    __device__ __forceinline__ void a_voff(const Unit&, unsigned (&v)[2][2], const int (&R)[2], const int (&C)[2]) const {
#pragma unroll
        for (int h = 0; h < 2; ++h)
#pragma unroll
            for (int i = 0; i < 2; ++i) v[h][i] = (unsigned)((h * HALF + R[i]) * KB + 2 * C[i]);
    }
};
template <bool GATHER, int KB_, int DT_ = (KB_ == 1024 ? 1 : 0)> struct ProbMoE {
    static constexpr bool GATHER_A = GATHER; static constexpr int KB = KB_, DT = DT_;
    const char* A; const char* Bt; const int* tokslot; const LAS int* tile_e; int ntile, nN, G, c, t0, xrot;
    __device__ __forceinline__ bool next(int i, Unit& u) const {
        if ((G & 7) == 0 && ((G >> 3) % nN) == 0) { const int per = (G >> 3) / nN, x = ((c & 7) - xrot) & 7, j = c >> 3; u.pm = t0 + (i * 8 + x) * per + j / nN; u.pn = j % nN; if (u.pm >= ntile) return false; }
        else { const int L = i * G + c; u.pm = t0 + L / nN; u.pn = L % nN; if (u.pm >= ntile) return false; }
        u.e = __builtin_amdgcn_readfirstlane(tile_e[u.pm]); return true;
    }
    __device__ __forceinline__ const char* a_base(const Unit& u) const { return GATHER ? A : A + (size_t)u.pm * (BM * KB); }
    __device__ __forceinline__ const char* b_base(const Unit& u) const { return Bt + ((size_t)u.e * nN + u.pn) * (size_t)(BM * KB); }
    __device__ __forceinline__ void a_voff(const Unit& u, unsigned (&v)[2][2], const int (&R)[2], const int (&C)[2]) const {
#pragma unroll
        for (int h = 0; h < 2; ++h)
#pragma unroll
            for (int i = 0; i < 2; ++i) { int tz = threadIdx.x; asm volatile("" : "+v"(tz)); int Rz, Cz; stage_rc(tz * 16 + i * 8192, Rz, Cz);
                const int row = GATHER ? tokslot[u.pm * BM + h * HALF + Rz] : (h * HALF + Rz); v[h][i] = (unsigned)(row * KB + 2 * Cz); }
    }
};

struct EpiProj {
    static constexpr bool PERM = true, PREF = false;
    bf16_t* PQ; const float* rope; const float* sa; const float* sb;
    __device__ __forceinline__ void operator()(f32x4 (&acc)[2][2][4][2], const Unit& u, int wr, int wc, int fr, int fq) const {
        const int row0 = u.pm * BM + wr * 64 + fr;
#pragma unroll
        for (int bj = 0; bj < 2; ++bj) { const float* sp = sb + u.pn * BM + bj * HALF + wc * 32 + 8 * fq; const f32x4 s0 = *(const f32x4*)sp, s1 = *(const f32x4*)(sp + 4);
#pragma unroll
            for (int ai = 0; ai < 2; ++ai)
#pragma unroll
                for (int m = 0; m < 4; ++m) { const float ra = sa[row0 + ai * HALF + m * 16]; acc[ai][bj][m][0] = acc[ai][bj][m][0] * (s0 * ra); acc[ai][bj][m][1] = acc[ai][bj][m][1] * (s1 * ra); } }
#pragma unroll
        for (int bj = 0; bj < 2; ++bj) {
            const int colb = u.pn * BM + bj * HALF + wc * 32;
            const float sc = (colb < COL_KA || (colb >= COL_QB && colb < COL_KB)) ? C2 : 1.f;
            if (colb >= COL_QB && colb < COL_VB && (colb & 32) == 0) {
                const float sg = (fq == 0) ? -1.f : ((fq == 1) ? 1.f : 0.f); const bool rl = fq < 2;
#pragma unroll
                for (int ai = 0; ai < 2; ++ai)
#pragma unroll
                    for (int m = 0; m < 4; ++m) {
                        const f32x4* rp = (const f32x4*)(rope + (size_t)(row0 + ai * HALF + m * 16) * 16);
#pragma unroll
                        for (int n = 0; n < 2; ++n) { const f32x4 ra = rp[2 * n], rb = rp[2 * n + 1]; f32x4 v = acc[ai][bj][m][n], p;
#pragma unroll
                            for (int j = 0; j < 4; ++j) p[j] = __shfl_xor(v[j], 16);
                            v[0] = v[0] * (rl ? ra[0] : 1.f) + sg * p[0] * ra[1]; v[1] = v[1] * (rl ? ra[2] : 1.f) + sg * p[1] * ra[3];
                            v[2] = v[2] * (rl ? rb[0] : 1.f) + sg * p[2] * rb[1]; v[3] = v[3] * (rl ? rb[2] : 1.f) + sg * p[3] * rb[3];
                            acc[ai][bj][m][n] = v; }
                        asm volatile("" : "+v"(acc[ai][bj][m][0]), "+v"(acc[ai][bj][m][1]) :: "memory");
                    }
            }
#pragma unroll
            for (int ai = 0; ai < 2; ++ai)
#pragma unroll
                for (int m = 0; m < 4; ++m) {
                    const int row = row0 + ai * HALF + m * 16;
                    const f32x4 v0 = acc[ai][bj][m][0] * sc, v1 = acc[ai][bj][m][1] * sc;
                    u32x4 w; w.x = cvt_pk_bf16(v0[0], v0[1]); w.y = cvt_pk_bf16(v0[2], v0[3]); w.z = cvt_pk_bf16(v1[0], v1[1]); w.w = cvt_pk_bf16(v1[2], v1[3]);
                    *(u32x4*)(PQ + (size_t)row * INW + colb + 8 * fq) = w;
                }
        }
    }
};
struct EpiOut {
    static constexpr bool PERM = true, PREF = false;
    const float* __restrict__ x; const float* __restrict__ mod; bf16_t* __restrict__ X1;
    __device__ __forceinline__ void operator()(const f32x4 (&acc)[2][2][4][2], const Unit& u, int wr, int wc, int fr, int fq) const {
        const int b = (u.pm * BM) / SEQ; const int col0 = u.pn * BM + wc * 32 + 8 * fq;
#pragma unroll
        for (int bj = 0; bj < 2; ++bj) { const int col = col0 + bj * HALF; const f32x4 g0 = *(const f32x4*)(mod + b * 6 * DM + 2 * DM + col), g1 = *(const f32x4*)(mod + b * 6 * DM + 2 * DM + col + 4);
#pragma unroll
            for (int ai = 0; ai < 2; ++ai) { f32x4 xa[4], xb[4];
#pragma unroll
                for (int m = 0; m < 4; ++m) { const size_t off = (size_t)(u.pm * BM + ai * HALF + wr * 64 + m * 16 + fr) * DM + col; xa[m] = *(const f32x4*)(x + off); xb[m] = *(const f32x4*)(x + off + 4); }
#pragma unroll
                for (int m = 0; m < 4; ++m) { const size_t off = (size_t)(u.pm * BM + ai * HALF + wr * 64 + m * 16 + fr) * DM + col;
                    const f32x4 v0 = xa[m] + g0 * acc[ai][bj][m][0], v1 = xb[m] + g1 * acc[ai][bj][m][1];
                    u32x4 w; w.x = cvt_pk_bf16(v0[0], v0[1]); w.y = cvt_pk_bf16(v0[2], v0[3]); w.z = cvt_pk_bf16(v1[0], v1[1]); w.w = cvt_pk_bf16(v1[2], v1[3]);
                    *(u32x4*)(X1 + off) = w; } } }
    }
};
struct EpiGateUp {
    static constexpr bool PERM = true, PREF = true;
    unsigned char* ACT; const float* bgu; const float* sas; const float* sbgu;
    __device__ __forceinline__ void prefetch(const Unit& u, LAS unsigned char* lds, int wid, int, int par) const {
        int tz = threadIdx.x; asm volatile("" : "+v"(tz)); const int lane = tz & 63;
        const unsigned dst = (unsigned)(size_t)(lds + L_EP + par * 3072); const unsigned vo = (lane < 32) ? (unsigned)lane * 16u : (unsigned)(DM * 4 + (lane - 32) * 16);
        if (wid == 0) glds16s((const char*)(bgu + (size_t)u.e * 2 * DM + u.pn * HALF), vo, (unsigned)__builtin_amdgcn_readfirstlane((int)dst));
        else if (wid == 1) glds16s((const char*)(sbgu + (size_t)u.e * 2 * DM + u.pn * HALF), vo, (unsigned)__builtin_amdgcn_readfirstlane((int)(dst + 1024)));
        else if (wid == 2) glds16s((const char*)(sas + (size_t)u.pm * BM), (unsigned)lane * 16u, (unsigned)__builtin_amdgcn_readfirstlane((int)(dst + 2048)));
    }
    __device__ __forceinline__ void run(const f32x4 (&acc)[2][2][4][2], const Unit& u, int wr, int wc, int fr, int fq, LAS unsigned char* lds, int par) const {
        const LAS float* ep = (const LAS float*)(lds + L_EP + par * 3072);
        const int j0 = u.pn * HALF + wc * 32 + 8 * fq, jl = wc * 32 + 8 * fq;
        const f32x4 bg0 = *(const LAS f32x4*)(ep + jl), bg1 = *(const LAS f32x4*)(ep + jl + 4), bu0 = *(const LAS f32x4*)(ep + 128 + jl), bu1 = *(const LAS f32x4*)(ep + 128 + jl + 4);
        const f32x4 sg0 = *(const LAS f32x4*)(ep + 256 + jl), sg1 = *(const LAS f32x4*)(ep + 256 + jl + 4), su0 = *(const LAS f32x4*)(ep + 384 + jl), su1 = *(const LAS f32x4*)(ep + 384 + jl + 4);
#pragma unroll
        for (int ai = 0; ai < 2; ++ai)
#pragma unroll
            for (int m = 0; m < 4; ++m) {
                const int rl = ai * HALF + wr * 64 + m * 16 + fr, row = u.pm * BM + rl; const float ra = ep[512 + rl];
                float o[8];
#pragma unroll
                for (int n = 0; n < 2; ++n) { const f32x4 ag = acc[ai][0][m][n], au = acc[ai][1][m][n], sg = n ? sg1 : sg0, su = n ? su1 : su0, bg = n ? bg1 : bg0, bu = n ? bu1 : bu0;
#pragma unroll
                    for (int h = 0; h < 2; ++h) {
                        const f32x2 g2 = (f32x2){ag[2 * h], ag[2 * h + 1]} * ((f32x2){sg[2 * h], sg[2 * h + 1]} * ra) + (f32x2){bg[2 * h], bg[2 * h + 1]};
                        const f32x2 u2 = (f32x2){au[2 * h], au[2 * h + 1]} * ((f32x2){su[2 * h], su[2 * h + 1]} * ra) + (f32x2){bu[2 * h], bu[2 * h + 1]};
                        f32x2 gate, uu; gate.x = fminf(g2.x, 7.f); gate.y = fminf(g2.y, 7.f); uu.x = __builtin_amdgcn_fmed3f(u2.x, -7.f, 7.f); uu.y = __builtin_amdgcn_fmed3f(u2.y, -7.f, 7.f);
                        const f32x2 t = gate * (-1.702f * LOG2E); f32x2 d; d.x = __builtin_amdgcn_exp2f(t.x); d.y = __builtin_amdgcn_exp2f(t.y); d = d + 1.f;
                        f32x2 r; r.x = __builtin_amdgcn_rcpf(d.x); r.y = __builtin_amdgcn_rcpf(d.y);
                        const f32x2 a = (uu * gate + gate) * (r * 8.f); o[4 * n + 2 * h] = a.x; o[4 * n + 2 * h + 1] = a.y; } }
                int w0 = __builtin_amdgcn_cvt_pk_fp8_f32(o[0], o[1], 0, false); w0 = __builtin_amdgcn_cvt_pk_fp8_f32(o[2], o[3], w0, true);
                int w1 = __builtin_amdgcn_cvt_pk_fp8_f32(o[4], o[5], 0, false); w1 = __builtin_amdgcn_cvt_pk_fp8_f32(o[6], o[7], w1, true);
                f32x2 st; st.x = __int_as_float(w0); st.y = __int_as_float(w1);
                *(f32x2*)(ACT + (size_t)row * DM + j0) = st;
            }
    }
};
struct EpiDown {
    static constexpr bool PERM = true, PREF = false;
    unsigned char* Y; const float* par;
    __device__ __forceinline__ void operator()(const f32x4 (&acc)[2][2][4][2], const Unit& u, int wr, int wc, int fr, int fq) const {
        const int col0 = u.pn * BM + wc * 32 + 8 * fq; const float* pp = par + ((size_t)u.e * (DM / 4) + (col0 >> 2)) * 8;
#pragma unroll
        for (int bj = 0; bj < 2; ++bj) { const f32x4 s0 = *(const f32x4*)(pp + bj * (HALF * 2)), b0 = *(const f32x4*)(pp + bj * (HALF * 2) + 4), s1 = *(const f32x4*)(pp + bj * (HALF * 2) + 8), b1 = *(const f32x4*)(pp + bj * (HALF * 2) + 12);
#pragma unroll
            for (int ai = 0; ai < 2; ++ai)
#pragma unroll
                for (int m = 0; m < 4; ++m) { const int row = u.pm * BM + ai * HALF + wr * 64 + m * 16 + fr;
                    const f32x4 v0 = acc[ai][bj][m][0] * s0 + b0, v1 = acc[ai][bj][m][1] * s1 + b1;
                    int w0 = __builtin_amdgcn_cvt_pk_fp8_f32(v0[0], v0[1], 0, false); w0 = __builtin_amdgcn_cvt_pk_fp8_f32(v0[2], v0[3], w0, true);
                    int w1 = __builtin_amdgcn_cvt_pk_fp8_f32(v1[0], v1[1], 0, false); w1 = __builtin_amdgcn_cvt_pk_fp8_f32(v1[2], v1[3], w1, true);
                    f32x2 o; o.x = __int_as_float(w0); o.y = __int_as_float(w1);
                    *(f32x2*)(Y + (size_t)row * DM + col0 + bj * HALF) = o;
                    if (m & 1) asm volatile("" ::: "memory"); }
            asm volatile("" ::: "memory"); }
    }
};

template <class Epi, class Prob>
__device__ __forceinline__ void gemm_phase(LAS unsigned char* lds, const Prob& S, const Epi& E) {
    const int tid = hid_tid(), wid = __builtin_amdgcn_readfirstlane(tid >> 6), lane = tid & 63, wr = wid >> 2, wc = wid & 3, fr = lane & 15, fq = lane >> 4;
    constexpr int KB = Prob::KB, nt = KB / (BK * 2);
    constexpr bool I8 = (Prob::DT == 1), F8 = (Prob::DT == 2);
    constexpr bool GA = Prob::GATHER_A;
    int Rr[2], Cc[2]; unsigned voffB[2], voffA[2];
#pragma unroll
    for (int i = 0; i < 2; ++i) { int R, C; stage_rc(tid * 16 + i * 8192, R, C); Rr[i] = R; Cc[i] = C; voffA[i] = (unsigned)(R * KB + 2 * C); const int Rb = Epi::PERM ? ((R & ~31) + perm32(R & 31)) : R; voffB[i] = (unsigned)(Rb * KB + 2 * C); }
    const size_t kstep = (size_t)(BK * 2);
    const size_t hstep = (size_t)HALF * KB;
    const unsigned ldsb = (unsigned)(size_t)lds;
    const unsigned ldsw = (unsigned)wid * 1024u;
    const unsigned ldsq = (unsigned)__builtin_amdgcn_readfirstlane((int)(ldsb + ldsw));
    const int aoff = lds_byte(wr * 64 + fr, fq * 8), boff = lds_byte(wc * 32 + fr, fq * 8);
#define PG8_SA(b, h) (((b) * 2 + (h)) * HTB)
#define PG8_SB(b, h) ((4 + (b) * 2 + (h)) * HTB)
#define PG8_STAGE(bufoff, gbase, voff) do { glds16i<(bufoff)>((const char*)(gbase), (voff)[0], ldsq); glds16i<(bufoff) + 8192>((const char*)(gbase), (voff)[1], ldsq); } while (0)
#define PG8_STAGE_A(bufoff, gbase, h, V) do { if constexpr (GA) { PG8_STAGE(bufoff, gbase, V[h]); } else { PG8_STAGE(bufoff, (gbase) + (h) * hstep, voffA); } } while (0)
#define PG8_LDA(dst, b, h) do { _Pragma("unroll") for (int m = 0; m < 4; ++m) { if constexpr (F8) dst##8[m] = __builtin_shufflevector(*(const LAS i32x4*)(lds + PG8_SA(b, h) + aoff + m * 2048), *(const LAS i32x4*)(lds + PG8_SA(b, h) + aoff + m * 2048 + 1024), 0, 1, 2, 3, 4, 5, 6, 7); \
        else { _Pragma("unroll") for (int k = 0; k < 2; ++k) dst[m][k] = *(const LAS bf16x8*)(lds + PG8_SA(b, h) + aoff + m * 2048 + k * 1024); } } } while (0)
#define PG8_LDB(dst, b, h) do { _Pragma("unroll") for (int n = 0; n < 2; ++n) { if constexpr (F8) dst##8[n] = __builtin_shufflevector(*(const LAS i32x4*)(lds + PG8_SB(b, h) + boff + n * 2048), *(const LAS i32x4*)(lds + PG8_SB(b, h) + boff + n * 2048 + 1024), 0, 1, 2, 3, 4, 5, 6, 7); \
        else { _Pragma("unroll") for (int k = 0; k < 2; ++k) dst[n][k] = *(const LAS bf16x8*)(lds + PG8_SB(b, h) + boff + n * 2048 + k * 1024); } } } while (0)
#define PG8_MMA(ai, bj, At, Bt) do { __builtin_amdgcn_s_setprio(1); _Pragma("unroll") for (int m = 0; m < 4; ++m) _Pragma("unroll") for (int n = 0; n < 2; ++n) _Pragma("unroll") for (int k = 0; k < 2; ++k) \
        { if constexpr (F8) { if (k == 0) acc[ai][bj][m][n] = __builtin_amdgcn_mfma_scale_f32_16x16x128_f8f6f4(Bt##8[n], At##8[m], acc[ai][bj][m][n], 0, 0, 0, 0, 0, 0); } \
          else if constexpr (I8) acc[ai][bj][m][n] = __builtin_bit_cast(f32x4, __builtin_amdgcn_mfma_i32_16x16x64_i8(__builtin_bit_cast(i32x4, Bt[n][k]), __builtin_bit_cast(i32x4, At[m][k]), __builtin_bit_cast(i32x4, acc[ai][bj][m][n]), 0, 0, 0)); \
          else acc[ai][bj][m][n] = __builtin_amdgcn_mfma_f32_16x16x32_bf16(Bt[n][k], At[m][k], acc[ai][bj][m][n], 0, 0, 0); } __builtin_amdgcn_s_setprio(0); } while (0)
#define PG8_WAIT_V(n) asm volatile("s_waitcnt vmcnt(" #n ")" ::: "memory")
#define PG8_WAIT_L(n) asm volatile("s_waitcnt lgkmcnt(" #n ")" ::: "memory")
#define PG8_BAR __builtin_amdgcn_s_barrier()
#define PG8_SCHED __builtin_amdgcn_sched_barrier(0)
    Unit cur, nxt; int ui = 0;
    if (!S.next(0, cur)) return;
    f32x4 acc[2][2][4][2];
#pragma unroll
    for (int a = 0; a < 2; ++a)
#pragma unroll
        for (int b = 0; b < 2; ++b)
#pragma unroll
            for (int m = 0; m < 4; ++m)
#pragma unroll
                for (int n = 0; n < 2; ++n) acc[a][b][m][n] = (f32x4){0.f, 0.f, 0.f, 0.f};
    bf16x8 At[4][2], B0[2][2], B1[2][2];
    i32x8 At8[4], B08[2], B18[2];
    unsigned cV[2][2], nV[2][2];
    if constexpr (GA) S.a_voff(cur, cV, Rr, Cc);
    const char* cA = S.a_base(cur); const char* cB = S.b_base(cur);
    PG8_STAGE(PG8_SB(0, 0), cB, voffB); PG8_STAGE(PG8_SB(0, 1), cB + hstep, voffB); PG8_STAGE_A(PG8_SA(0, 0), cA, 0, cV); PG8_STAGE_A(PG8_SA(0, 1), cA, 1, cV);
    if (wr == 1) PG8_BAR;
    PG8_WAIT_V(2); PG8_BAR;
    PG8_STAGE(PG8_SB(1, 0), cB + kstep, voffB); PG8_STAGE_A(PG8_SA(1, 0), cA + kstep, 0, cV); PG8_STAGE(PG8_SB(1, 1), cB + hstep + kstep, voffB);
    PG8_WAIT_V(6); PG8_BAR;
    for (;;) {
        if constexpr (Epi::PREF) E.prefetch(cur, lds, wid, lane, ui & 1);
        const bool has_next = S.next(ui + 1, nxt);
        const char* nA = has_next ? S.a_base(nxt) : cA; const char* nB = has_next ? S.b_base(nxt) : cB;
        if constexpr (GA) { if (has_next) S.a_voff(nxt, nV, Rr, Cc);
        else {
#pragma unroll
            for (int h = 0; h < 2; ++h)
#pragma unroll
                for (int i = 0; i < 2; ++i) nV[h][i] = cV[h][i];
        } }
#define PG8_KBODY(A1, A2, B2, A3, B3, V2) do { \
              \
            PG8_LDB(B0, 0, 0); PG8_LDB(B1, 0, 1); PG8_SCHED; PG8_LDA(At, 0, 0); PG8_STAGE_A(PG8_SA(1, 1), A1, 1, cV); \
            PG8_WAIT_V(8); PG8_WAIT_L(0); PG8_BAR; PG8_MMA(0, 0, At, B0); PG8_MMA(0, 1, At, B1); PG8_BAR; PG8_SCHED; \
              \
            PG8_LDA(At, 0, 1); PG8_STAGE(PG8_SB(0, 0), B2, voffB); PG8_STAGE(PG8_SB(0, 1), (B2) + hstep, voffB); PG8_STAGE_A(PG8_SA(0, 0), A2, 0, V2); \
            PG8_WAIT_V(8); PG8_WAIT_L(0); PG8_BAR; PG8_MMA(1, 0, At, B0); PG8_MMA(1, 1, At, B1); PG8_BAR; PG8_SCHED; \
              \
            PG8_LDB(B0, 1, 0); PG8_LDB(B1, 1, 1); PG8_SCHED; PG8_LDA(At, 1, 0); PG8_STAGE_A(PG8_SA(0, 1), A2, 1, V2); \
            PG8_WAIT_V(8); PG8_WAIT_L(0); PG8_BAR; PG8_MMA(0, 0, At, B0); PG8_MMA(0, 1, At, B1); PG8_BAR; PG8_SCHED; \
              \
            PG8_LDA(At, 1, 1); PG8_STAGE(PG8_SB(1, 0), B3, voffB); PG8_STAGE(PG8_SB(1, 1), (B3) + hstep, voffB); PG8_STAGE_A(PG8_SA(1, 0), A3, 0, V2); \
            PG8_WAIT_V(8); PG8_WAIT_L(0); PG8_BAR; PG8_MMA(1, 0, At, B0); PG8_MMA(1, 1, At, B1); PG8_BAR; PG8_SCHED; } while (0)
        if constexpr (GA) {
            for (int t = 0; t < nt - 2; t += 2) {
                const char* a1 = cA + (size_t)(t + 1) * kstep; const char* a2 = a1 + kstep; const char* b2 = cB + (size_t)(t + 2) * kstep;
                PG8_KBODY(a1, a2, b2, a2 + kstep, b2 + kstep, cV);
            }
            { const char* a1 = cA + (size_t)(nt - 1) * kstep; PG8_KBODY(a1, nA, nB, nA + kstep, nB + kstep, nV); }
        } else {
            for (int t = 0; t < nt; t += 2) {
                const bool last = (t == nt - 2);
                const char* a1 = cA + (size_t)(t + 1) * kstep;
                const char* a2 = last ? nA : cA + (size_t)(t + 2) * kstep; const char* b2 = last ? nB : cB + (size_t)(t + 2) * kstep;
                PG8_KBODY(a1, a2, b2, a2 + kstep, b2 + kstep, cV);
            }
        }
#undef PG8_KBODY
        if (wr == 0) PG8_BAR;
        PG8_SCHED;
        if constexpr (I8) {
#pragma unroll
            for (int a = 0; a < 2; ++a)
#pragma unroll
                for (int b = 0; b < 2; ++b)
#pragma unroll
                    for (int m = 0; m < 4; ++m)
#pragma unroll
                        for (int n = 0; n < 2; ++n) acc[a][b][m][n] = __builtin_convertvector(__builtin_bit_cast(i32x4, acc[a][b][m][n]), f32x4); }
        { int tz = threadIdx.x; asm volatile("" : "+v"(tz)); const int l2 = tz & 63; if constexpr (Epi::PREF) E.run(acc, cur, wr, wc, l2 & 15, l2 >> 4, lds, ui & 1); else E(acc, cur, wr, wc, l2 & 15, l2 >> 4); }
        if (!has_next) break;
#pragma unroll
        for (int a = 0; a < 2; ++a)
#pragma unroll
            for (int b = 0; b < 2; ++b)
#pragma unroll
                for (int m = 0; m < 4; ++m)
#pragma unroll
                    for (int n = 0; n < 2; ++n) acc[a][b][m][n] = (f32x4){0.f, 0.f, 0.f, 0.f};
        cur = nxt; cA = nA; cB = nB; ++ui;
        if constexpr (GA) {
#pragma unroll
            for (int h = 0; h < 2; ++h)
#pragma unroll
                for (int i = 0; i < 2; ++i) cV[h][i] = nV[h][i]; }
        if (wr == 1) PG8_BAR;
    }
    PG8_WAIT_V(0);
    PG8_BAR;
#undef PG8_SA
#undef PG8_SB
#undef PG8_STAGE
#undef PG8_STAGE_A
#undef PG8_LDA
#undef PG8_LDB
#undef PG8_MMA
#undef PG8_WAIT_V
#undef PG8_WAIT_L
#undef PG8_BAR
#undef PG8_SCHED
}
}


__device__ __forceinline__ void moe_tables(const int* hist, LAS unsigned char* lds) {
    LAS int* poff = (LAS int*)(lds + L_POFF); LAS int* tot = (LAS int*)(lds + L_TOT); LAS int* tile_e = (LAS int*)(lds + L_TILEE); LAS int* part = (LAS int*)(lds + L_PART);
    const int tid = hid_tid();
    { const int e = tid & 31, p = tid >> 5; int s = 0;
#pragma unroll
        for (int q = 0; q < 16; ++q) s += hist[(p * 16 + q) * NE + e];
        part[p * NE + e] = s; }
    __syncthreads();
    if (tid < NE) { int s = 0;
#pragma unroll
        for (int p = 0; p < 16; ++p) s += part[p * NE + tid];
        tot[tid] = s; }
    __syncthreads();
    if (tid == 0) { int o = 0; for (int e = 0; e < NE; ++e) { poff[e] = o; o += ((tot[e] + 255) >> 8) << 8; } poff[NE] = o; }
    __syncthreads();
    if (tid < 320) { const int s0 = tid * 256; int e = 0; for (int q = 0; q < NE; ++q) if (poff[q] <= s0) e = q; tile_e[tid] = e; }
    __syncthreads();
}

struct WItem { const float* W; int ldw; bf16_t* WT; int dst, k0, n0; };
__device__ __forceinline__ void transpose_emit(const f32x4 (&v)[8], const WItem& it, LAS float*, int lane) {
    bf16_t* op = it.WT + (size_t)(it.dst + 4 * (lane & 7)) * DM + it.k0 + 8 * (lane >> 3);
#pragma unroll
    for (int q = 0; q < 4; ++q) { u32x4 o; o.x = pg8::cvt_pk_bf16(v[0][q], v[1][q]); o.y = pg8::cvt_pk_bf16(v[2][q], v[3][q]); o.z = pg8::cvt_pk_bf16(v[4][q], v[5][q]); o.w = pg8::cvt_pk_bf16(v[6][q], v[7][q]);
        *(u32x4*)(op + (size_t)q * DM) = o; }
}
__device__ __forceinline__ void transpose_load(f32x4 (&v)[8], const WItem& it, int lane) {
    const unsigned voff = (unsigned)((8 * (lane >> 3)) * it.ldw + 4 * (lane & 7)) * 4u; const char* wb = (const char*)(it.W + (size_t)it.k0 * it.ldw + it.n0);
#pragma unroll
    for (int i = 0; i < 8; ++i) v[i] = *(const f32x4*)(wb + (size_t)i * it.ldw * 4 + voff);
}
__device__ __forceinline__ void transpose_pair(const WItem& a, const WItem& b, LAS float* scr, int lane) {
    f32x4 va[8], vb[8]; transpose_load(va, a, lane); transpose_load(vb, b, lane);
    transpose_emit(va, a, scr, lane); transpose_emit(vb, b, scr, lane);
}
constexpr int I_IN = 16 * (INW / 32), I_OUT = 16 * (DM / 32), I_GU = 16 * (2 * DM / 32), I_D = 16 * (DM / 32);
constexpr int N_SMALL_ITEMS = I_IN + I_OUT;
__device__ __forceinline__ WItem witem_small(CtxK& C, int r) {
    if (r < I_IN) { const int kb = r / (INW / 32), nb = r % (INW / 32); return WItem{C.w_in, INW, WSP(bf16_t, WS_WIN_T), 32 * nb, 64 * kb, 32 * nb}; }
    r -= I_IN; const int kb = r / (DM / 32), nb = r % (DM / 32); return WItem{C.w_out, DM, WSP(bf16_t, WS_WOUT_T), 32 * nb, 64 * kb, 32 * nb};
}
__device__ __forceinline__ WItem witem_moe(CtxK& C, int r) {
    if (r < NE * I_GU) { const int e = r / I_GU, q = r % I_GU, kb = q / (2 * DM / 32), nb = q % (2 * DM / 32), n0 = 32 * nb;
        const int dst = (n0 < DM) ? (256 * (n0 >> 7) + (n0 & 127)) : (256 * ((n0 - DM) >> 7) + 128 + ((n0 - DM) & 127));
        return WItem{C.w_gate_up + (size_t)e * DM * 2 * DM, 2 * DM, WSP(bf16_t, WS_WGU_T) + (size_t)e * 2 * DM * DM, dst, 64 * kb, n0}; }
    r -= NE * I_GU; const int e = r / I_D, q = r % I_D, kb = q / (DM / 32), nb = q % (DM / 32);
    return WItem{C.w_down + (size_t)e * DM * DM, DM, WSP(bf16_t, WS_WD_T) + (size_t)e * DM * DM, 32 * nb, 64 * kb, 32 * nb};
}
__device__ __forceinline__ unsigned q8(float x, float inv) { int q = __float2int_rn(x * inv); q = q < -127 ? -127 : (q > 127 ? 127 : q); return (unsigned)q & 255u; }
__device__ __forceinline__ unsigned pack_q8(float a, float b, float c, float d, float inv) { return q8(a, inv) | (q8(b, inv) << 8) | (q8(c, inv) << 16) | (q8(d, inv) << 24); }
__device__ __forceinline__ void phase_weights(CtxK& C, LAS unsigned char* lds, int gw, int ngw, int wave, int lane) {
    LAS float* scr = (LAS float*)(lds + RING_OFF + wave * 16384);
    for (int it = 2 * gw; it < I_OUT; it += 2 * ngw) transpose_pair(witem_small(C, I_IN + it), witem_small(C, I_IN + it + 1), scr, lane);
    unsigned* cmax = WSP(unsigned, WS_CTL) + CW_CMAX_IN;
    for (int it = gw; it < I_IN; it += ngw) { const WItem w = witem_small(C, it); f32x4 v[8]; transpose_load(v, w, lane);
        f32x4 m = __builtin_elementwise_abs(v[0]);
#pragma unroll
        for (int i = 1; i < 8; ++i) m = __builtin_elementwise_max(m, __builtin_elementwise_abs(v[i]));
#pragma unroll
        for (int q = 0; q < 4; ++q) { float a = m[q]; a = fmaxf(a, __shfl_xor(a, 8)); a = fmaxf(a, __shfl_xor(a, 16)); a = fmaxf(a, __shfl_xor(a, 32)); m[q] = a; }
        if (lane < 8) {
#pragma unroll
            for (int q = 0; q < 4; ++q) atomicMax(cmax + w.n0 + 4 * lane + q, __float_as_uint(m[q])); }
    }
}
__device__ __forceinline__ void phase_quant_win(CtxK& C, int gw, int ngw, int lane) {
    const unsigned* cmax = WSP(unsigned, WS_CTL) + CW_CMAX_IN; unsigned char* W8 = WSP(unsigned char, WS_WIN8); float* sb = WSP(float, WS_SBIN);
    for (int it = gw; it < I_IN; it += ngw) { const WItem w = witem_small(C, it); f32x4 v[8]; transpose_load(v, w, lane);
        const int r = lane >> 3, c4 = lane & 7;
#pragma unroll
        for (int q = 0; q < 4; ++q) { const int n = w.n0 + 4 * c4 + q; const float cm = __uint_as_float(__hip_atomic_load(cmax + n, __ATOMIC_RELAXED, __HIP_MEMORY_SCOPE_AGENT)); const float inv = cm > 0.f ? 127.f / cm : 0.f;
            f32x2 o; o.x = __uint_as_float(pack_q8(v[0][q], v[1][q], v[2][q], v[3][q], inv)); o.y = __uint_as_float(pack_q8(v[4][q], v[5][q], v[6][q], v[7][q], inv));
            *(f32x2*)(W8 + (size_t)n * DM + w.k0 + 8 * r) = o;
            if (w.k0 == 0 && r == 0) sb[n] = cm * (1.f / 127.f); }
    }
}
__device__ __forceinline__ f32x4 colmax_regs(const f32x4 (&v)[8]) {
    f32x4 m = __builtin_elementwise_abs(v[0]);
#pragma unroll
    for (int i = 1; i < 8; ++i) m = __builtin_elementwise_max(m, __builtin_elementwise_abs(v[i]));
#pragma unroll
    for (int q = 0; q < 4; ++q) { float a = m[q]; a = fmaxf(a, __shfl_xor(a, 8)); a = fmaxf(a, __shfl_xor(a, 16)); a = fmaxf(a, __shfl_xor(a, 32)); m[q] = a; }
    return m;
}
__device__ __forceinline__ void quant_regs16(const f32x4 (&lo)[8], const f32x4 (&hi)[8], f32x4 cm, unsigned char* dst  ) {
#pragma unroll
    for (int q = 0; q < 4; ++q) { const float inv = cm[q] > 0.f ? 127.f / cm[q] : 0.f;
        u32x4 o; o.x = pack_q8(lo[0][q], lo[1][q], lo[2][q], lo[3][q], inv); o.y = pack_q8(lo[4][q], lo[5][q], lo[6][q], lo[7][q], inv);
        o.z = pack_q8(hi[0][q], hi[1][q], hi[2][q], hi[3][q], inv); o.w = pack_q8(hi[4][q], hi[5][q], hi[6][q], hi[7][q], inv);
        *(u32x4*)(dst + (size_t)q * DM) = o; }
}
__device__ __forceinline__ unsigned pack_f8(float a, float b, float c, float d, float inv) { int w = __builtin_amdgcn_cvt_pk_fp8_f32(a * inv, b * inv, 0, false); w = __builtin_amdgcn_cvt_pk_fp8_f32(c * inv, d * inv, w, true); return (unsigned)w; }
__device__ __forceinline__ void quant_regs16_f8(const f32x4 (&lo)[8], const f32x4 (&hi)[8], f32x4 cm, unsigned char* dst) {
#pragma unroll
    for (int q = 0; q < 4; ++q) { const float inv = cm[q] > 0.f ? 448.f / cm[q] : 0.f;
        u32x4 o; o.x = pack_f8(lo[0][q], lo[1][q], lo[2][q], lo[3][q], inv); o.y = pack_f8(lo[4][q], lo[5][q], lo[6][q], lo[7][q], inv);
        o.z = pack_f8(hi[0][q], hi[1][q], hi[2][q], hi[3][q], inv); o.w = pack_f8(hi[4][q], hi[5][q], hi[6][q], hi[7][q], inv);
        *(u32x4*)(dst + (size_t)q * DM) = o; }
}
constexpr int N_SCHUNKS = NE * 64, N_ZCHUNKS = NE * 32;
template <int KIND> __device__ __forceinline__ void chunk_dma(CtxK& C, LAS unsigned char* lds, int chunk, int wave, int lane) {
    constexpr int PITCH = KIND ? DM : 2 * DM, HSPE = PITCH / 32;
    const int e = chunk / HSPE, n0 = 32 * (chunk % HSPE);
    const char* wb = (const char*)((KIND ? C.w_down : C.w_gate_up) + (size_t)e * DM * PITCH + (size_t)(128 * wave) * PITCH + n0);
    const unsigned voff = (unsigned)((lane >> 3) * PITCH + 4 * (lane & 7)) * 4u;
    const unsigned ldsq = (unsigned)__builtin_amdgcn_readfirstlane((int)((unsigned)(size_t)(lds + RING_OFF) + (unsigned)wave * 16384u));
#define CH_DMA(b) pg8::glds16i<(b) * 1024>(wb + (size_t)(b) * 8 * PITCH * 4, voff, ldsq)
    CH_DMA(0); CH_DMA(1); CH_DMA(2); CH_DMA(3); CH_DMA(4); CH_DMA(5); CH_DMA(6); CH_DMA(7); CH_DMA(8); CH_DMA(9); CH_DMA(10); CH_DMA(11); CH_DMA(12); CH_DMA(13); CH_DMA(14); CH_DMA(15);
#undef CH_DMA
}
__device__ __forceinline__ void chunk_read(f32x4 (&lo)[8], f32x4 (&hi)[8], LAS unsigned char* lds, int wave, int lane) {
    const LAS unsigned char* pb = lds + RING_OFF + wave * 16384 + (lane >> 3) * 2048 + (lane & 7) * 16;
#pragma unroll
    for (int i = 0; i < 8; ++i) { lo[i] = *(const LAS f32x4*)(pb + i * 128); hi[i] = *(const LAS f32x4*)(pb + 1024 + i * 128); }
}
template <int KIND> __device__ __forceinline__ void chunk_emit(CtxK& C, const f32x4 (&lo)[8], const f32x4 (&hi)[8], f32x4 cm, int chunk, int wave, int lane) {
    constexpr int PITCH = KIND ? DM : 2 * DM, HSPE = PITCH / 32;
    const int e = chunk / HSPE, n0 = 32 * (chunk % HSPE), r = lane >> 3, c4 = lane & 7, kA = 128 * wave;
    if constexpr (KIND == 0) {
        const int dst0 = (n0 < DM) ? (256 * (n0 >> 7) + (n0 & 127)) : (256 * ((n0 - DM) >> 7) + 128 + ((n0 - DM) & 127));
        unsigned char* W8e = WSP(unsigned char, WS_WGU8) + (size_t)e * 2 * DM * DM;
        quant_regs16(lo, hi, cm, W8e + (size_t)(dst0 + 4 * c4) * DM + kA + 16 * r);
        if (wave == 0 && lane < 8) { float* sbe = WSP(float, WS_SBGU) + e * 2 * DM + n0; *(f32x4*)(sbe + 4 * lane) = cm * (1.f / 127.f); }
    } else {
        unsigned char* W8e = WSP(unsigned char, WS_WD8) + (size_t)e * DM * DM;
        quant_regs16_f8(lo, hi, cm, W8e + (size_t)(n0 + 4 * c4) * DM + kA + 16 * r);
        if (wave == 0 && lane < 8) { float* sbe = WSP(float, WS_SBD) + ((size_t)e * (DM / 4) + (n0 >> 2) + lane) * 8;
            *(f32x4*)sbe = cm * (1.f / (448.f * 8.f)); *(f32x4*)(sbe + 4) = *(const f32x4*)(C.b_down + (size_t)e * DM + n0 + 4 * lane); }
    }
}

__device__ __forceinline__ void phase_proj(CtxK& C, LAS unsigned char* lds) {
    pg8::ProbDense<1024> S; S.init(WSP(char, WS_H8), WSP(char, WS_WIN8), NTOK, INW, (int)gridDim.x, (int)blockIdx.x);
    pg8::EpiProj E{WSP(bf16_t, WS_PQ), WSP(float, WS_ROPE), WSP(float, WS_SA), WSP(float, WS_SBIN)};
    if ((blockIdx.x >> 3) & 1) { __builtin_amdgcn_s_sleep(127); __builtin_amdgcn_s_sleep(127); }
    pg8::gemm_phase<pg8::EpiProj, pg8::ProbDense<1024>>(lds + RING_OFF, S, E);
}
__device__ __forceinline__ void phase_out(CtxK& C, LAS unsigned char* lds) {
    pg8::ProbDense<2048> S; S.init(WSP(bf16_t, WS_MIX), WSP(bf16_t, WS_WOUT_T), NTOK, DM, (int)gridDim.x, (int)blockIdx.x);
    pg8::EpiOut E{C.x, WSP(float, WS_MOD), WSP(bf16_t, WS_X1)};
    pg8::gemm_phase<pg8::EpiOut, pg8::ProbDense<2048>>(lds + RING_OFF, S, E);
}
__device__ __forceinline__ void phase_gate_up(CtxK& C, LAS unsigned char* lds, const int t0, const int ntile, const int xrot) {
    pg8::ProbMoE<true, 1024> S{(const char*)WSP(char, WS_H8F), (const char*)WSP(char, WS_WGU8), WSP(int, WS_TOKSLOT), (const LAS int*)(lds + L_TILEE), ntile, 8, (int)gridDim.x, (int)blockIdx.x, t0, xrot};
    pg8::EpiGateUp E{WSP(unsigned char, WS_ACT), C.b_gate_up, WSP(float, WS_SAS), WSP(float, WS_SBGU)};
    pg8::gemm_phase<pg8::EpiGateUp, pg8::ProbMoE<true, 1024>>(lds + RING_OFF, S, E);
}
__device__ __forceinline__ void phase_down(CtxK& C, LAS unsigned char* lds, const int t0, const int ntile, const int xrot) {
    pg8::ProbMoE<false, 1024, 2> S{(const char*)WSP(char, WS_ACT), (const char*)WSP(char, WS_WD8), WSP(int, WS_TOKSLOT), (const LAS int*)(lds + L_TILEE), ntile, 4, (int)gridDim.x, (int)blockIdx.x, t0, xrot};
    pg8::EpiDown E{WSP(unsigned char, WS_Y), WSP(float, WS_SBD)};
    pg8::gemm_phase<pg8::EpiDown, pg8::ProbMoE<false, 1024, 2>>(lds + RING_OFF, S, E);
}


namespace attn_body {
using bf16=__hip_bfloat16;
using bf16x8=__attribute__((ext_vector_type(8)))short;
using s16x4=__attribute__((ext_vector_type(4)))short;
using f32x16=__attribute__((ext_vector_type(16)))float;
using u32x4=__attribute__((ext_vector_type(4)))unsigned;
constexpr int D=64,PIN=3072,POUT=1024;
constexpr int NW=8,QBLK=32,QB=QBLK*NW,KVBLK=64,NQB=SEQ/QB;
__device__ __forceinline__ int crow(int r,int hi){return (r&3)+8*(r>>2)+4*hi;}
#define SBAR() __builtin_amdgcn_sched_barrier(0)
__device__ __forceinline__ void negall(f32x16&p0,f32x16&p1){
  const float NEG=-INFINITY;
  #pragma unroll
  for(int r=0;r<16;++r){p0[r]=NEG;p1[r]=NEG;}
}
typedef __attribute__((address_space(3))) const float* lds_cfptr;
__device__ __forceinline__ void bias_add(f32x16&p0,f32x16&p1,int dc,int qi,int hi,lds_cfptr tab){
  const int base=dc*64+qi-4*hi+128;
  #pragma unroll
  for(int g=0;g<4;++g){
    #pragma unroll
    for(int j=0;j<4;++j){const int r=4*g+j; const int k=(r&3)+8*(r>>2); int i0=base-k,i1=base-k-32; i0=i0>256?256:i0; i1=i1>256?256:i1; p0[r]+=tab[i0]; p1[r]+=tab[i1];}
    asm volatile("":"+v"(p0),"+v"(p1)::"memory"); }
}

constexpr int NSLOT=3, SLOTB=8192;
constexpr int LDS_K=0, LDS_V=NSLOT*SLOTB;
constexpr int LDS_BYTES=LDS_V+2*NSLOT*SLOTB+NW*64*4+NW*4096+1280;
constexpr float C2=0.125f*1.4426950408889634f;
__device__ __forceinline__ void glds16(const void*gsrc,unsigned lds_dst){unsigned keep;
  asm volatile("s_mov_b32 %0, m0\n\ts_mov_b32 m0, %2\n\ts_nop 0\n\tglobal_load_lds_dwordx4 %1, off\n\ts_mov_b32 m0, %0":"=&s"(keep):"v"(gsrc),"s"(lds_dst):"memory");}
__device__ __forceinline__ float max3f(float a,float b,float c){float r;asm("v_max3_f32 %0, %1, %2, %3":"=v"(r):"v"(a),"v"(b),"v"(c));return r;}
__device__ __forceinline__ float max2f(float a,float b){float r;asm("v_max_f32_e32 %0, %1, %2":"=v"(r):"v"(a),"v"(b));return r;}
__device__ __forceinline__ float fadd_s(float a,float b){float r;asm("v_add_f32_e32 %0, %1, %2":"=v"(r):"v"(a),"v"(b));return r;}
__device__ __forceinline__ float fsub_s(float a,float b){float r;asm("v_sub_f32_e32 %0, %1, %2":"=v"(r):"v"(a),"v"(b));return r;}
typedef float f32x2_t __attribute__((ext_vector_type(2))); typedef __bf16 bf16x2_t __attribute__((ext_vector_type(2)));
__device__ __forceinline__ unsigned cvtpk_s(float lo,float hi){f32x2_t v={lo,hi};bf16x2_t b=__builtin_convertvector(v,bf16x2_t);return __builtin_bit_cast(unsigned,b);}
#define WAIT_BAR(N) asm volatile("s_waitcnt vmcnt(" #N ") lgkmcnt(0)\n\ts_barrier":::"memory")

__device__ __forceinline__ void qkt(f32x16&p0,f32x16&p1,const char*Kslot,const bf16x8*qr,const f32x16&negm,int r32,int hi){
  const char*kb=Kslot+hi*1024+r32*16;
  #pragma unroll
  for(int d0=0;d0<4;++d0){
    const bf16x8 b0=*reinterpret_cast<const bf16x8*>(kb+d0*2048);
    const bf16x8 b1=*reinterpret_cast<const bf16x8*>(kb+d0*2048+512);
    if(d0==0){p0=__builtin_amdgcn_mfma_f32_32x32x16_bf16(b0,qr[0],negm,0,0,0);p1=__builtin_amdgcn_mfma_f32_32x32x16_bf16(b1,qr[0],negm,0,0,0);}
    else{p0=__builtin_amdgcn_mfma_f32_32x32x16_bf16(b0,qr[d0],p0,0,0,0);p1=__builtin_amdgcn_mfma_f32_32x32x16_bf16(b1,qr[d0],p1,0,0,0);}}
}
typedef __attribute__((address_space(3))) const char* lds_cptr;
typedef short v4i16_t __attribute__((ext_vector_type(4)));
__device__ __forceinline__ void kload8(bf16x8*kf,lds_cptr kp){
  kf[0]=*(const __attribute__((address_space(3))) bf16x8*)(kp);      kf[1]=*(const __attribute__((address_space(3))) bf16x8*)(kp+512);
  kf[2]=*(const __attribute__((address_space(3))) bf16x8*)(kp+2048); kf[3]=*(const __attribute__((address_space(3))) bf16x8*)(kp+2560);
  kf[4]=*(const __attribute__((address_space(3))) bf16x8*)(kp+4096); kf[5]=*(const __attribute__((address_space(3))) bf16x8*)(kp+4608);
  kf[6]=*(const __attribute__((address_space(3))) bf16x8*)(kp+6144); kf[7]=*(const __attribute__((address_space(3))) bf16x8*)(kp+6656);
}
__device__ __forceinline__ void kload2(bf16x8*kf,lds_cptr kp,int j){ kf[2*j]=*(const __attribute__((address_space(3))) bf16x8*)(kp+j*2048); kf[2*j+1]=*(const __attribute__((address_space(3))) bf16x8*)(kp+j*2048+512); }
__device__ __forceinline__ s16x4 vtr(lds_cptr p){ return __builtin_bit_cast(s16x4,__builtin_amdgcn_ds_read_tr16_b64_v4i16((__attribute__((address_space(3))) v4i16_t*)p)); }
__device__ __forceinline__ float rowmax(const f32x16&p0,const f32x16&p1){
  float a=max3f(p0[0],p0[1],p1[0]),b=max3f(p0[2],p0[3],p1[1]);a=max3f(a,p1[2],p1[3]);
  #pragma unroll
  for(int r=4;r<16;r+=4){a=max3f(a,p0[r],p0[r+1]);b=max3f(b,p0[r+2],p0[r+3]);a=max3f(a,p1[r],p1[r+1]);b=max3f(b,p1[r+2],p1[r+3]);}
  const float m=max2f(a,b);
  auto rr=__builtin_amdgcn_permlane32_swap(__float_as_uint(m),__float_as_uint(m),false,false);
  return max2f(__uint_as_float(rr[0]),__uint_as_float(rr[1]));
}
template<int NDQ> __device__ __forceinline__ void pv(f32x16*o,int vb,bf16x8 pa0,bf16x8 pa1,bf16x8 pa2,bf16x8 pa3){
  #pragma unroll
  for(int d0=0;d0<NDQ;++d0){s16x4 lo[4],hi[4];
    #pragma unroll
    for(int ks=0;ks<4;++ks){
      asm volatile("ds_read_b64_tr_b16 %0,%1 offset:%c2":"=&v"(lo[ks]):"v"(vb),"i"(d0*4096+ks*1024):"memory");
      asm volatile("ds_read_b64_tr_b16 %0,%1 offset:%c2":"=&v"(hi[ks]):"v"(vb),"i"(d0*4096+ks*1024+512):"memory");}
    asm volatile("s_waitcnt lgkmcnt(0)":::"memory");SBAR();
    #define PK(k) (bf16x8){lo[k][0],lo[k][1],lo[k][2],lo[k][3],hi[k][0],hi[k][1],hi[k][2],hi[k][3]}
    o[d0]=__builtin_amdgcn_mfma_f32_32x32x16_bf16(pa0,PK(0),o[d0],0,0,0);
    o[d0]=__builtin_amdgcn_mfma_f32_32x32x16_bf16(pa1,PK(1),o[d0],0,0,0);
    o[d0]=__builtin_amdgcn_mfma_f32_32x32x16_bf16(pa2,PK(2),o[d0],0,0,0);
    o[d0]=__builtin_amdgcn_mfma_f32_32x32x16_bf16(pa3,PK(3),o[d0],0,0,0);
    #undef PK
  }
}

#ifndef ATTN_STORE16
#define ATTN_STORE16(p,v) (*(u32x4*)(p)=(v))
#endif
template<int MODE,int THRL> __device__ __forceinline__ void attn_unit(int b,int qb,const bf16*Qc,const bf16*__restrict__ Kc,const bf16*__restrict__ Vc,bf16*Oc,const float*bias_h,char*shm){
  const int tid=hid_tid(),lane=tid&63,r32=lane&31,hi=lane>>5; const int wid=__builtin_amdgcn_readfirstlane(tid>>6);
  const long rowbase=(long)b*SEQ; const int q0=qb*QB;
  const bf16*Qw=Qc+(rowbase+q0+wid*QBLK)*PIN;
  const bf16*Kh=Kc+rowbase*PIN,*Vh=Vc+rowbase*PIN;
  const unsigned lds0=(unsigned)(uintptr_t)shm;
  constexpr int NDQ=(MODE==1)?4:2, VSL=(MODE==1)?2:1;
  constexpr int LDS_WS=LDS_V+VSL*NSLOT*SLOTB, LDS_OST=LDS_WS+NW*64*4, LDS_TAB=LDS_OST+NW*4096;
  float*wsf=(float*)(shm+LDS_WS)+wid*64;
  const bf16*ksrc=Kh+(long)lane*PIN+wid*8;
  const bf16*vsrc=Vh+(long)(16*(wid&3)+(lane>>2))*PIN+(wid>>2)*32+(lane&3)*8;
  const unsigned kdst=lds0+LDS_K+wid*1024, vdst=lds0+LDS_V+wid*1024;
  const int lo_=(MODE==0)?((4*qb-8)>0?(4*qb-8):0):0; const int NT=(MODE==0)?(4*qb+4-lo_):(q0+QB)/KVBLK; const int rot_=4*qb-lo_;
  #define TIDX(t) ((MODE==0)?(lo_+(((t)+rot_)>=NT?((t)+rot_-NT):((t)+rot_))):(t))
  #define DMA_K(t,slot) glds16(ksrc+(long)TIDX(t)*KVBLK*PIN,(unsigned)__builtin_amdgcn_readfirstlane(kdst+(slot)))
  #define DMA_V(t,slot) do{ glds16(vsrc+(long)TIDX(t)*KVBLK*PIN,(unsigned)__builtin_amdgcn_readfirstlane(vdst+VSL*(slot))); \
      if(MODE==1) glds16(vsrc+(long)TIDX(t)*KVBLK*PIN+64,(unsigned)__builtin_amdgcn_readfirstlane(vdst+VSL*(slot)+8192)); }while(0)
  const int vb0=(int)(lds0+LDS_V)+((lane>>4)&1)*32+(lane&3)*8+(4*hi+((lane&15)>>2))*64;
  const char*Kbase=shm+LDS_K; bf16x8 kf[8];
  const lds_cptr shm3=(lds_cptr)shm; const lds_cptr kp0=shm3+LDS_K+hi*1024+r32*16; const lds_cptr vp0=shm3+LDS_V+((lane>>4)&1)*32+(lane&3)*8+(4*hi+((lane&15)>>2))*64;
  const lds_cfptr tab=(lds_cfptr)(shm3+LDS_TAB);
  if(MODE==0){ int tz=threadIdx.x; asm volatile("":"+v"(tz)); if(tz<257){ ((__attribute__((address_space(3))) float*)(shm3+LDS_TAB))[tz]=(bias_h[tz]-bias_h[256])*1.4426950408889634f; } }
  DMA_K(0,0);DMA_V(0,0);DMA_K(1,SLOTB);
  bf16x8 qr[4];
  #pragma unroll
  for(int d0=0;d0<4;++d0)qr[d0]=*reinterpret_cast<const bf16x8*>(&Qw[(long)r32*PIN+d0*16+hi*8]);
  float mhat=0.f,l_reg=0.f;f32x16 o[NDQ]; _Pragma("unroll") for(int d_=0;d_<NDQ;++d_)o[d_]=f32x16{}; constexpr bool USE_NEGM=false; f32x16 negm=f32x16{};if(USE_NEGM)asm volatile("":"+v"(negm));
  const int cqw=4*qb+(wid>>1), qi=(wid&1)*32+r32;
  #define HOOK(P0,P1,t) do{ if(MODE==1){ const int jb_=(t)-(NT-4); if(jb_>(wid>>1))negall(P0,P1); } else { const int dc_=cqw-TIDX(t); if(dc_<0||dc_>8)negall(P0,P1); else if(dc_<=2)bias_add(P0,P1,dc_,qi,hi,tab); } }while(0)
  #define CMASK(P0,P1,t) HOOK(P0,P1,t)
  bool resc=false;
    \
  #define START(P0,P1) do{ const float rm=rowmax(P0,P1); resc=false; \
    if(__any(rm>(float)THRL)){ const float dl=__builtin_fmaxf(rm,0.f); mhat=fadd_s(mhat,dl); \
      _Pragma("unroll") for(int r=0;r<16;++r){P0[r]=fsub_s(P0[r],dl);P1[r]=fsub_s(P1[r],dl);} \
      if(USE_NEGM){ _Pragma("unroll") for(int r=0;r<16;++r)negm[r]=-mhat; asm volatile("":"+v"(negm)); } } \
    _Pragma("unroll") for(int r=0;r<16;++r)P0[r]=__builtin_amdgcn_exp2f(P0[r]); }while(0)
  #define RESC() do{ if(resc){ asm volatile("s_waitcnt lgkmcnt(0)":::"memory"); \
      _Pragma("unroll") for(int d_=0;d_<NDQ;++d_) _Pragma("unroll") for(int r=0;r<16;++r)o[d_][r]*=wsf[crow(r,hi)]; } }while(0)
  f32x16 pA0,pA1,pB0,pB1;
  int sl_prev=0,sl_cur=0,sl_next=SLOTB;
  #define ROT() do{sl_prev=sl_cur;sl_cur=sl_next;sl_next=(sl_next==(NSLOT-1)*SLOTB)?0:sl_next+SLOTB;}while(0)
  DMA_K(2,2*SLOTB);
  WAIT_BAR(3);
  qkt(pA0,pA1,Kbase,qr,negm,r32,hi);asm volatile("s_nop 15\n\ts_nop 7":"+v"(pA0),"+v"(pA1));CMASK(pA0,pA1,0);
  START(pA0,pA1);
  _Pragma("unroll") for(int r=0;r<16;++r)pA1[r]=__builtin_amdgcn_exp2f(pA1[r]);
  WAIT_BAR(0);
  DMA_K(3,0);DMA_V(1,SLOTB);
  ROT();
  kload8(kf,kp0+sl_cur);
  if(MODE==1){WAIT_BAR(3);}else{WAIT_BAR(2);}
  s16x4 vlo[8],vhi[8]; u32x4 pw0,pw1,pw2,pw3;
  #define PKW(P,B) cvtpk_s(P[B],P[B+1])
  #define PAF(k) __builtin_bit_cast(bf16x8,pw##k)
  #define VFR(i) (bf16x8){vlo[i][0],vlo[i][1],vlo[i][2],vlo[i][3],vhi[i][0],vhi[i][1],vhi[i][2],vhi[i][3]}
  #define PIN(x) asm volatile("":"+v"(x))
  #define MX3(a,b,c) __builtin_fmaxf(__builtin_fmaxf((a),(b)),(c))
  #define GAPA(MF,A0,A1,A2,A3,W0,W1,PW) do{ MF; sacc+=A0; sacc+=A1; sacc+=A2; sacc+=A3; PIN(sacc); W0; W1; PIN(PW); SBAR(); }while(0)
  #define EX(v) __builtin_amdgcn_exp2f(v)
  #define GAPB(MF,X,B) do{ MF; X[B]=EX(X[B]); X[B+1]=EX(X[B+1]); X[B+2]=EX(X[B+2]); X[B+3]=EX(X[B+3]); PIN(X); SBAR(); }while(0)
  #define VRD(i) do{ vlo[i]=vtr(vp_+(((i)>>2)*4096+((i)&3)*1024)); vhi[i]=vtr(vp_+(((i)>>2)*4096+((i)&3)*1024+512)); }while(0)
  #define VRD2(i) do{ vlo[i]=vtr(vp_+((((i)>>2)+2)*4096+((i)&3)*1024)); vhi[i]=vtr(vp_+((((i)>>2)+2)*4096+((i)&3)*1024+512)); }while(0)
  #define GAPB2(MF,X,B) do{ MF; X[B]=EX(X[B]); X[B+1]=EX(X[B+1]); PIN(X); SBAR(); }while(0)
  #define KRD(G,j) do{ if(G){ kload2(kf,kp0+sl_next,j); SBAR(); } }while(0)
  #define STEP(C0,C1,P0,P1,t,GK,GV,GL) do{ SBAR(); \
    const lds_cptr vp_=vp0+VSL*sl_prev; \
    VRD(0); SBAR(); float sacc=(P0[0]+P0[1]); \
    GAPA(C0=__builtin_amdgcn_mfma_f32_32x32x16_bf16(kf[0],qr[0],negm,0,0,0), P0[2],P0[3],P0[4],P0[5],     pw0[0]=PKW(P0,0), pw0[1]=PKW(P0,2), pw0); \
    VRD(4); SBAR(); GAPA(C1=__builtin_amdgcn_mfma_f32_32x32x16_bf16(kf[1],qr[0],negm,0,0,0), P0[6],P0[7],P0[8],P0[9],     pw0[2]=PKW(P0,4), pw0[3]=PKW(P0,6), pw0); \
    VRD(1); SBAR(); GAPA(C0=__builtin_amdgcn_mfma_f32_32x32x16_bf16(kf[2],qr[1],C0,0,0,0),   P0[10],P0[11],P0[12],P0[13], pw1[0]=PKW(P0,8), pw1[1]=PKW(P0,10), pw1); \
    VRD(5); SBAR(); GAPA(C1=__builtin_amdgcn_mfma_f32_32x32x16_bf16(kf[3],qr[1],C1,0,0,0),   P0[14],P0[15],P1[0],P1[1],   pw1[2]=PKW(P0,12),pw1[3]=PKW(P0,14), pw1); \
    VRD(2); SBAR(); GAPA(C0=__builtin_amdgcn_mfma_f32_32x32x16_bf16(kf[4],qr[2],C0,0,0,0),   P1[2],P1[3],P1[4],P1[5],     pw2[0]=PKW(P1,0), pw2[1]=PKW(P1,2), pw2); \
    VRD(6); SBAR(); GAPA(C1=__builtin_amdgcn_mfma_f32_32x32x16_bf16(kf[5],qr[2],C1,0,0,0),   P1[6],P1[7],P1[8],P1[9],     pw2[2]=PKW(P1,4), pw2[3]=PKW(P1,6), pw2); \
    VRD(3); SBAR(); GAPA(C0=__builtin_amdgcn_mfma_f32_32x32x16_bf16(kf[6],qr[3],C0,0,0,0),   P1[10],P1[11],P1[12],P1[13], pw3[0]=PKW(P1,8), pw3[1]=PKW(P1,10), pw3); \
    VRD(7); SBAR(); GAPA(C1=__builtin_amdgcn_mfma_f32_32x32x16_bf16(kf[7],qr[3],C1,0,0,0),   P1[14],P1[15],0.f,0.f,       pw3[2]=PKW(P1,12),pw3[3]=PKW(P1,14), pw3); \
    l_reg+=sacc; \
    if(GK){DMA_K((t)+3,sl_cur);} if(GV){DMA_V((t)+1,sl_next);} \
    if(!USE_NEGM){ if(__any(mhat!=0.f)){ _Pragma("unroll") for(int r=0;r<16;++r){C0[r]-=mhat;C1[r]-=mhat;} } } \
    CMASK(C0,C1,t); \
    { float a=MX3(C0[0],C0[1],C1[0]),b=MX3(C0[2],C0[3],C1[1]); a=MX3(a,C1[2],C1[3]); \
      _Pragma("unroll") for(int r=4;r<16;r+=4){a=MX3(a,C0[r],C0[r+1]);b=MX3(b,C0[r+2],C0[r+3]);a=MX3(a,C1[r],C1[r+1]);b=MX3(b,C1[r+2],C1[r+3]);} \
      float rm=__builtin_fmaxf(a,b); { auto rr=__builtin_amdgcn_permlane32_swap(__float_as_uint(rm),__float_as_uint(rm),false,false); rm=__builtin_fmaxf(__uint_as_float(rr[0]),__uint_as_float(rr[1])); } \
      resc=false; \
      if(__builtin_expect(__any(rm>(float)THRL),0)){ const float dl=__builtin_fmaxf(rm,0.f); mhat+=dl; \
        _Pragma("unroll") for(int r=0;r<16;++r){C0[r]-=dl;C1[r]-=dl;} \
        if(USE_NEGM){ _Pragma("unroll") for(int r=0;r<16;++r)negm[r]=-mhat; asm volatile("":"+v"(negm)); } \
        const float f=__builtin_amdgcn_exp2f(-dl); l_reg*=f; if(hi==0)wsf[r32]=f; resc=true; } } \
    SBAR(); \
    if(MODE!=1){ \
    GAPB(o[0]=__builtin_amdgcn_mfma_f32_32x32x16_bf16(PAF(0),VFR(0),o[0],0,0,0), C0,0); \
    GAPB(o[1]=__builtin_amdgcn_mfma_f32_32x32x16_bf16(PAF(0),VFR(4),o[1],0,0,0), C0,4); \
    KRD(GL,0); GAPB(o[0]=__builtin_amdgcn_mfma_f32_32x32x16_bf16(PAF(1),VFR(1),o[0],0,0,0), C0,8); \
    KRD(GL,1); GAPB(o[1]=__builtin_amdgcn_mfma_f32_32x32x16_bf16(PAF(1),VFR(5),o[1],0,0,0), C0,12); \
    KRD(GL,2); GAPB(o[0]=__builtin_amdgcn_mfma_f32_32x32x16_bf16(PAF(2),VFR(2),o[0],0,0,0), C1,0); \
    KRD(GL,3); GAPB(o[1]=__builtin_amdgcn_mfma_f32_32x32x16_bf16(PAF(2),VFR(6),o[1],0,0,0), C1,4); \
    GAPB(o[0]=__builtin_amdgcn_mfma_f32_32x32x16_bf16(PAF(3),VFR(3),o[0],0,0,0), C1,8); \
    GAPB(o[1]=__builtin_amdgcn_mfma_f32_32x32x16_bf16(PAF(3),VFR(7),o[1],0,0,0), C1,12); \
    } else {   \
    GAPB2(o[0]=__builtin_amdgcn_mfma_f32_32x32x16_bf16(PAF(0),VFR(0),o[0],0,0,0), C0,0);  VRD2(0); SBAR(); \
    GAPB2(o[1]=__builtin_amdgcn_mfma_f32_32x32x16_bf16(PAF(0),VFR(4),o[1],0,0,0), C0,2);  VRD2(4); SBAR(); \
    KRD(GL,0); GAPB2(o[0]=__builtin_amdgcn_mfma_f32_32x32x16_bf16(PAF(1),VFR(1),o[0],0,0,0), C0,4);  VRD2(1); SBAR(); \
    KRD(GL,1); GAPB2(o[1]=__builtin_amdgcn_mfma_f32_32x32x16_bf16(PAF(1),VFR(5),o[1],0,0,0), C0,6);  VRD2(5); SBAR(); \
    KRD(GL,2); GAPB2(o[0]=__builtin_amdgcn_mfma_f32_32x32x16_bf16(PAF(2),VFR(2),o[0],0,0,0), C0,8);  VRD2(2); SBAR(); \
    KRD(GL,3); GAPB2(o[1]=__builtin_amdgcn_mfma_f32_32x32x16_bf16(PAF(2),VFR(6),o[1],0,0,0), C0,10); VRD2(6); SBAR(); \
    GAPB2(o[0]=__builtin_amdgcn_mfma_f32_32x32x16_bf16(PAF(3),VFR(3),o[0],0,0,0), C0,12); VRD2(3); SBAR(); \
    GAPB2(o[1]=__builtin_amdgcn_mfma_f32_32x32x16_bf16(PAF(3),VFR(7),o[1],0,0,0), C0,14); VRD2(7); SBAR(); \
    GAPB2(o[NDQ-2]=__builtin_amdgcn_mfma_f32_32x32x16_bf16(PAF(0),VFR(0),o[NDQ-2],0,0,0), C1,0); \
    GAPB2(o[NDQ-1]=__builtin_amdgcn_mfma_f32_32x32x16_bf16(PAF(0),VFR(4),o[NDQ-1],0,0,0), C1,2); \
    GAPB2(o[NDQ-2]=__builtin_amdgcn_mfma_f32_32x32x16_bf16(PAF(1),VFR(1),o[NDQ-2],0,0,0), C1,4); \
    GAPB2(o[NDQ-1]=__builtin_amdgcn_mfma_f32_32x32x16_bf16(PAF(1),VFR(5),o[NDQ-1],0,0,0), C1,6); \
    GAPB2(o[NDQ-2]=__builtin_amdgcn_mfma_f32_32x32x16_bf16(PAF(2),VFR(2),o[NDQ-2],0,0,0), C1,8); \
    GAPB2(o[NDQ-1]=__builtin_amdgcn_mfma_f32_32x32x16_bf16(PAF(2),VFR(6),o[NDQ-1],0,0,0), C1,10); \
    GAPB2(o[NDQ-2]=__builtin_amdgcn_mfma_f32_32x32x16_bf16(PAF(3),VFR(3),o[NDQ-2],0,0,0), C1,12); \
    GAPB2(o[NDQ-1]=__builtin_amdgcn_mfma_f32_32x32x16_bf16(PAF(3),VFR(7),o[NDQ-1],0,0,0), C1,14); \
    } \
    }while(0)
  int t=1;
  #undef CMASK
  #define CMASK(P0,P1,t) do{}while(0)
  for(;(MODE==1)&&t+5<NT;t+=2){
    STEP(pB0,pB1,pA0,pA1,t,true,true,true);     WAIT_BAR(3); RESC(); ROT();
    STEP(pA0,pA1,pB0,pB1,t+1,true,true,true);   WAIT_BAR(3); RESC(); ROT();
  }
  #undef CMASK
  #define CMASK(P0,P1,t) HOOK(P0,P1,t)
  #define ENDW(tt) do{ if((tt)+3<NT){ if(MODE==1){WAIT_BAR(3);}else{WAIT_BAR(2);} } else if((tt)+2<NT){ if(MODE==1){WAIT_BAR(2);}else{WAIT_BAR(1);} } else {WAIT_BAR(0);} }while(0)
  for(;t+1<NT;t+=2){
    STEP(pB0,pB1,pA0,pA1,t,(t+3<NT),(t+1<NT),(t+1<NT));       ENDW(t);   RESC(); ROT();
    STEP(pA0,pA1,pB0,pB1,t+1,(t+4<NT),(t+2<NT),(t+2<NT));     ENDW(t+1); RESC(); ROT();
  }
  STEP(pB0,pB1,pA0,pA1,NT-1,false,false,false); RESC();
  { float sacc=pB0[0]+pB0[1]; _Pragma("unroll") for(int r=2;r<16;++r)sacc+=pB0[r]; _Pragma("unroll") for(int r=0;r<16;++r)sacc+=pB1[r]; l_reg+=sacc;
    pw0=(u32x4){PKW(pB0,0),PKW(pB0,2),PKW(pB0,4),PKW(pB0,6)};pw1=(u32x4){PKW(pB0,8),PKW(pB0,10),PKW(pB0,12),PKW(pB0,14)};pw2=(u32x4){PKW(pB1,0),PKW(pB1,2),PKW(pB1,4),PKW(pB1,6)};pw3=(u32x4){PKW(pB1,8),PKW(pB1,10),PKW(pB1,12),PKW(pB1,14)};
    SBAR(); pv<NDQ>(o,vb0+VSL*sl_cur,PAF(0),PAF(1),PAF(2),PAF(3)); }
  #undef PKW
  #undef PAF
  #undef VFR
  #undef PIN
  #undef MX3
  #undef GAPA
  #undef GAPB
  #undef EX
  #undef VRD
  #undef VRD2
  #undef GAPB2
  #undef KRD
  #undef STEP
  #undef ENDW
  {auto rr=__builtin_amdgcn_permlane32_swap(__float_as_uint(l_reg),__float_as_uint(l_reg),false,false);l_reg=__uint_as_float(rr[0])+__uint_as_float(rr[1]);}
  if(hi==0)wsf[32+r32]=l_reg;asm volatile("s_waitcnt lgkmcnt(0)":::"memory");
  float rli[16];
  #pragma unroll
  for(int r=0;r<16;++r)rli[r]=__builtin_amdgcn_rcpf(wsf[32+crow(r,hi)]);
  bf16*Ow=Oc+(rowbase+q0+wid*QBLK)*POUT;
  { bf16*stg=(bf16*)(shm+LDS_OST)+wid*2048;
    int tz_=threadIdx.x; asm volatile("":"+v"(tz_)); const int lz=tz_&63;
    #pragma unroll
    for(int hh_=0;hh_<NDQ/2;++hh_){
      #pragma unroll
      for(int r=0;r<16;++r){const int orow=crow(r,hi);
        #pragma unroll
        for(int d0=0;d0<2;++d0)stg[orow*64+d0*32+r32]=__float2bfloat16(o[2*hh_+d0][r]*rli[r]);}
      asm volatile("s_waitcnt lgkmcnt(0)":::"memory");
      #pragma unroll
      for(int i=0;i<4;++i){const int row=i*8+(lz>>3),ch=lz&7; const u32x4 v=*(const u32x4*)(stg+row*64+ch*8); ATTN_STORE16(Ow+(long)row*POUT+hh_*64+ch*8,v);}
      asm volatile("s_waitcnt lgkmcnt(0)":::"memory"); } }
  asm volatile("s_waitcnt lgkmcnt(0)\n\ts_barrier":::"memory");
  #undef DMA_K
  #undef DMA_V
  #undef CMASK
  #undef HOOK
  #undef TIDX
  #undef START
  #undef RESC
  #undef ROT
}
constexpr int ATTN_LDS_BYTES=LDS_BYTES;
#undef SBAR
#undef WAIT_BAR
}


constexpr int N_BUNITS = NB * 8 * 16, N_AUNITS = NB * 8 * 16;
__device__ __forceinline__ void run_chunks(CtxK& C, LAS unsigned char* lds, const int cwc) {
    const int tid = hid_tid(), wave = __builtin_amdgcn_readfirstlane(tid >> 6), lane = tid & 63;
    unsigned* ctl = WSP(unsigned, WS_CTL);
    LAS int* tk = (LAS int*)(lds + L_MISC);
    LAS f32x4* exch = (LAS f32x4*)(lds + L_EP);
    if (tid == 0) tk[0] = (int)__hip_atomic_fetch_add(ctl + cwc, 1u, __ATOMIC_RELAXED, __HIP_MEMORY_SCOPE_AGENT);
    __syncthreads();
    int cur = __builtin_amdgcn_readfirstlane(tk[0]), par = 1;
    if (cur < N_SCHUNKS) chunk_dma<0>(C, lds, cur, wave, lane); else if (cur < N_SCHUNKS + N_ZCHUNKS) chunk_dma<1>(C, lds, cur - N_SCHUNKS, wave, lane);
    while (cur < N_SCHUNKS + N_ZCHUNKS) {
        int nx = 0; if (tid == 0) nx = (int)__hip_atomic_fetch_add(ctl + cwc, 1u, __ATOMIC_RELAXED, __HIP_MEMORY_SCOPE_AGENT);
        asm volatile("s_waitcnt vmcnt(0)" ::: "memory");
        f32x4 lo[8], hi[8]; chunk_read(lo, hi, lds, wave, lane);
        const f32x4 m = __builtin_elementwise_max(colmax_regs(lo), colmax_regs(hi));
        if (lane < 8) exch[par * 64 + wave * 8 + lane] = m;
        if (tid == 0) tk[par] = nx;
        __syncthreads();
        const int nxt = __builtin_amdgcn_readfirstlane(tk[par]);
        if (nxt < N_SCHUNKS) chunk_dma<0>(C, lds, nxt, wave, lane); else if (nxt < N_SCHUNKS + N_ZCHUNKS) chunk_dma<1>(C, lds, nxt - N_SCHUNKS, wave, lane);
        f32x4 cm = exch[par * 64 + (lane & 7)];
#pragma unroll
        for (int w8 = 1; w8 < 8; ++w8) cm = __builtin_elementwise_max(cm, exch[par * 64 + w8 * 8 + (lane & 7)]);
        if (cur < N_SCHUNKS) chunk_emit<0>(C, lo, hi, cm, cur, wave, lane); else chunk_emit<1>(C, lo, hi, cm, cur - N_SCHUNKS, wave, lane);
        cur = nxt; par ^= 1;
    }
    asm volatile("s_waitcnt vmcnt(0)" ::: "memory");
    __syncthreads();
}
__device__ __forceinline__ void phase_attn(CtxK& C, unsigned char* lds_gen, LAS unsigned char* lds, const int cwb0 = CW_QB, const int cwa = CW_QA, const int cwc = CW_QC) {
    static_assert(attn_body::ATTN_LDS_BYTES <= RING_BYTES, "attention scratch fits the ring region");
    const bool conv_first = ((blockIdx.x >> 3) & 7) >= 5;
    if (conv_first) run_chunks(C, lds, cwc);
    const int tid = hid_tid();
    unsigned* ctl = WSP(unsigned, WS_CTL);
    LAS int* tk = (LAS int*)(lds + L_MISC);
    const attn_body::bf16* PQ = (const attn_body::bf16*)WSP(bf16_t, WS_PQ);
    attn_body::bf16* OC = (attn_body::bf16*)WSP(bf16_t, WS_OC); attn_body::bf16* MIX = (attn_body::bf16*)WSP(bf16_t, WS_MIX);
    for (int brep = 0; brep < ((PROBE_DBL & 32768) ? 2 : 1); ++brep) {
    const int cwb = cwb0 + 512 * brep;
    if (tid == 0) tk[0] = (int)__hip_atomic_fetch_add(ctl + cwb, 1u, __ATOMIC_RELAXED, __HIP_MEMORY_SCOPE_AGENT);
    __syncthreads();
    for (;;) {
        const int cur = __builtin_amdgcn_readfirstlane(tk[0]);
        if (cur >= N_BUNITS) break;
        int nxt = 0; if (tid == 0) nxt = (int)__hip_atomic_fetch_add(ctl + cwb, 1u, __ATOMIC_RELAXED, __HIP_MEMORY_SCOPE_AGENT);
        const int qb = 15 - (cur >> 5), j = cur & 31, b = j >> 3, hh = (j >> 1) & 3, comp = j & 1;
        attn_body::attn_unit<1, 8>(b, qb, PQ + COL_QB + hh * 128 + comp * 64, PQ + COL_KB + hh * 128 + comp * 64, PQ + COL_VB + hh * 128,
                                   OC + comp * 512 + hh * 128, nullptr, (char*)lds_gen + RING_OFF);
        if (tid == 0) tk[0] = nxt;
        __syncthreads();
    }
    __syncthreads();
    }
    if (tid == 0) tk[0] = (int)__hip_atomic_fetch_add(ctl + cwa, 1u, __ATOMIC_RELAXED, __HIP_MEMORY_SCOPE_AGENT);
    __syncthreads();
    for (;;) {
        const int cur = __builtin_amdgcn_readfirstlane(tk[0]);
        if (cur >= N_AUNITS) break;
        int nxt = 0; if (tid == 0) nxt = (int)__hip_atomic_fetch_add(ctl + cwa, 1u, __ATOMIC_RELAXED, __HIP_MEMORY_SCOPE_AGENT);
        const int qb = 15 - (cur >> 5), j = cur & 31, b = j >> 3, h = j & 7;
        attn_body::attn_unit<0, 8>(b, qb, PQ + COL_QA + h * 64, PQ + COL_KA + h * 64, PQ + COL_VA + h * 64, MIX + h * 64, C.rel_bias + h * 257, (char*)lds_gen + RING_OFF);
        if (tid == 0) tk[0] = nxt;
        __syncthreads();
    }
    __syncthreads();
    if (!conv_first) run_chunks(C, lds, cwc);
}
__device__ __forceinline__ void phase_combine(CtxK& C, int gw, int ngw, int lane) {
    const float lam = expf(wave_sum(C.lq1[lane] * C.lk1[lane])) - expf(wave_sum(C.lq2[lane] * C.lk2[lane])) + LAMBDA_INIT;
    const bf16_t* OC = WSP(bf16_t, WS_OC); bf16_t* MIX = WSP(bf16_t, WS_MIX);
    const int d0 = (lane & 15) * 8;
    float g[8];
#pragma unroll
    for (int i = 0; i < 8; ++i) g[i] = C.g_subln[d0 + i] * (1.f - LAMBDA_INIT);
    for (int row = gw; row < NTOK; row += ngw) {
        const u32x4 a = *(const u32x4*)(OC + (size_t)row * DM + lane * 8), bq = *(const u32x4*)(OC + (size_t)row * DM + 512 + lane * 8);
        float y[8]; float ss = 0.f;
#pragma unroll
        for (int i = 0; i < 4; ++i) { const unsigned ua = a[i], ub = bq[i];
            y[2 * i] = __uint_as_float(ua << 16) - lam * __uint_as_float(ub << 16); y[2 * i + 1] = __uint_as_float(ua & 0xffff0000u) - lam * __uint_as_float(ub & 0xffff0000u);
            ss += y[2 * i] * y[2 * i] + y[2 * i + 1] * y[2 * i + 1]; }
        ss += __shfl_xor(ss, 1); ss += __shfl_xor(ss, 2); ss += __shfl_xor(ss, 4); ss += __shfl_xor(ss, 8);
        const float rstd = rsqrtf(ss * (1.f / 128.f) + EPS);
        u32x4 o;
#pragma unroll
        for (int i = 0; i < 4; ++i) o[i] = pg8::cvt_pk_bf16(y[2 * i] * rstd * g[2 * i], y[2 * i + 1] * rstd * g[2 * i + 1]);
        *(u32x4*)(MIX + (size_t)row * DM + 512 + lane * 8) = o;
    }
}

#define XB_TMO      128
#define XB_XCNT(j)  (256  + 64 * (j))
#define XB_XSUB(j)  (1280 + 64 * (j))
#define XB_XGEN(j)  (2304 + 64 * (j))
#define XB_TOP      3328
#define XB_TOPGEN   3392
#define XCD_BAR_WORDS 3456
#define XB_SPIN_CAP (1u << 18)

__device__ __forceinline__ unsigned xb_ld(unsigned* p)              { return __hip_atomic_load(p, __ATOMIC_RELAXED, __HIP_MEMORY_SCOPE_AGENT); }
__device__ __forceinline__ unsigned xb_add(unsigned* p, unsigned v) { return __hip_atomic_fetch_add(p, v, __ATOMIC_RELAXED, __HIP_MEMORY_SCOPE_AGENT); }
__device__ __forceinline__ unsigned xb_xcc_id() { return (unsigned)__builtin_amdgcn_s_getreg((3 << 11) | 20) & 0xFu; }
#define XB_SPIN(cond, bar) do { unsigned _sp = 0; while (cond) { __builtin_amdgcn_s_sleep(1); \
    if ((++_sp & 255u) == 0u) { if (xb_ld(&(bar)[XB_TMO])) break; if (_sp > XB_SPIN_CAP) { atomicAdd(&(bar)[XB_TMO], 1u); break; } } } } while (0)

struct XcdBarrier {
    unsigned* bar; unsigned x;
    volatile LAS unsigned* st;
};

__device__ __forceinline__ XcdBarrier xcd_barrier_post(unsigned* bar, volatile LAS unsigned* st) {
    XcdBarrier b; b.bar = bar; b.x = xb_xcc_id(); b.st = st;
    if (threadIdx.x == 0) (void)xb_add(&bar[XB_XCNT(b.x)], 1u);
    return b;
}
__device__ __forceinline__ void xcd_barrier_complete(unsigned* bar, unsigned x, unsigned& nloc, unsigned& nx) {
    const unsigned G = gridDim.x * gridDim.y * gridDim.z;
    unsigned sum, cnt, mine, sp = 0u;
    for (;;) {
        sum = 0u; cnt = 0u; mine = 0u;
#pragma unroll
        for (unsigned j = 0; j < 16; ++j) { const unsigned c = xb_ld(&bar[XB_XCNT(j)]); sum += c; cnt += (c > 0u) ? 1u : 0u; mine = (j == x) ? c : mine; }
        if (sum == G) break;
        __builtin_amdgcn_s_sleep(1);
        if ((++sp & 255u) == 0u) { if (xb_ld(&bar[XB_TMO])) break; if (sp > XB_SPIN_CAP) { atomicAdd(&bar[XB_TMO], 1u); break; } }
    }
    nloc = mine > 0u ? mine : 1u; nx = cnt > 0u ? cnt : 1u;
}

__device__ __forceinline__ void xcd_barrier(const XcdBarrier& b) {
    asm volatile("s_waitcnt vmcnt(0)" ::: "memory");
    __syncthreads();
    if (threadIdx.x == 0) {
        unsigned* bar = b.bar;
        __builtin_amdgcn_s_waitcnt(0);
        unsigned nloc = b.st[0], nx = b.st[1];
        if (nloc == 0u) { xcd_barrier_complete(bar, b.x, nloc, nx); b.st[0] = nloc; b.st[1] = nx; }
        const unsigned old = xb_add(&bar[XB_XSUB(b.x)], 1u);
        const unsigned gen = old / nloc;
        if (old + 1u == (gen + 1u) * nloc) {
            __builtin_amdgcn_fence(__ATOMIC_RELEASE, "agent");
            asm volatile("s_waitcnt vmcnt(0)" ::: "memory");
            const unsigned og = xb_add(&bar[XB_TOP], 1u);
            const unsigned tg = og / nx;
            if (og + 1u == (tg + 1u) * nx) xb_add(&bar[XB_TOPGEN], 1u);
            else XB_SPIN(xb_ld(&bar[XB_TOPGEN]) == tg, bar);
            __builtin_amdgcn_fence(__ATOMIC_ACQUIRE, "agent");
            xb_add(&bar[XB_XGEN(b.x)], 1u);
            asm volatile("s_waitcnt vmcnt(0)" ::: "memory");
        } else {
            XB_SPIN(xb_ld(&bar[XB_XGEN(b.x)]) == gen, bar);
            __builtin_amdgcn_fence(__ATOMIC_ACQUIRE, "agent");
            asm volatile("s_waitcnt vmcnt(0)" ::: "memory");
        }
    }
    __syncthreads();
}

__device__ __forceinline__ void phase_mod_partials(CtxK& C, int gw, int ngw, int lane) {
    float* part = WSP(float, WS_MODP);
    for (int it = gw; it < 96 * MODP_KC; it += ngw) {
        const int jb = it % 96, kc = it / 96, j = jb * 64 + lane, k0 = kc * 64;
        float sv[4], acc[4];
#pragma unroll
        for (int b = 0; b < 4; ++b) { const float cv = C.c[b * DM + k0 + lane]; sv[b] = cv / (1.f + expf(-cv)); acc[b] = 0.f; }
        const float* wp = C.w_ada + (size_t)k0 * (6 * DM) + j;
#pragma unroll 8
        for (int kk = 0; kk < 64; ++kk) { const float w = wp[(size_t)kk * (6 * DM)];
#pragma unroll
            for (int b = 0; b < 4; ++b) acc[b] += __shfl(sv[b], kk) * w; }
#pragma unroll
        for (int b = 0; b < 4; ++b) part[(size_t)(kc * 4 + b) * (6 * DM) + j] = acc[b];
    }
}
__device__ __forceinline__ void phase_rope_misc(CtxK& C, int gt, int nt) {
    float* rope = WSP(float, WS_ROPE);
    for (int idx = gt; idx < NTOK * 8; idx += nt) {
        const int row = idx >> 3, i = idx & 7;
        float f = 1.0f;
        f = (i == 1) ? 0.1939227432012558f : f; f = (i == 2) ? 0.03760603070259094f : f; f = (i == 3) ? 0.007292664609849453f : f; f = (i == 4) ? 0.0014142135623842478f : f;
        f = (i == 5) ? 0.00027424818836152554f : f; f = (i == 6) ? 5.3182957344688475e-05f : f; f = (i == 7) ? 1.0313385246263351e-05f : f;
        const float ang = (float)C.positions[row] * f;
        rope[2 * idx] = cosf(ang); rope[2 * idx + 1] = sinf(ang);
    }
    int* ts = WSP(int, WS_TOKSLOT);
    for (int idx = gt; idx < NSLOT_MAX; idx += nt) ts[idx] = 0;
    for (int idx = gt; idx < NE * (DM / 8); idx += nt) { const int e = idx & 31, ko = idx >> 5; float w[8];
#pragma unroll
        for (int j = 0; j < 8; ++j) w[j] = C.w_router[(size_t)(8 * ko + j) * NE + e];
        u32x4 o; o.x = pg8::cvt_pk_bf16(w[0], w[1]); o.y = pg8::cvt_pk_bf16(w[2], w[3]); o.z = pg8::cvt_pk_bf16(w[4], w[5]); o.w = pg8::cvt_pk_bf16(w[6], w[7]);
        *(u32x4*)(WSP(bf16_t, WS_WRT) + (size_t)e * DM + 8 * ko) = o; }

}
__device__ __forceinline__ float mod_reduce(CtxK& C, int b, int j) {
    const float* part = WSP(float, WS_MODP); float s = C.b_ada[j];
#pragma unroll
    for (int kc = 0; kc < MODP_KC; ++kc) s += part[(size_t)(kc * 4 + b) * (6 * DM) + j];
    return s;
}
__device__ __forceinline__ void phase_norm1(CtxK& C, LAS unsigned char* lds) {
    const int tid = hid_tid(), lane = tid & 63, wv = tid >> 6;
    LAS float* shs = (LAS float*)(lds + RING_OFF);
    float* mod = WSP(float, WS_MOD); unsigned char* H8 = WSP(unsigned char, WS_H8); float* sa = WSP(float, WS_SA);
    for (int blk = blockIdx.x; blk < NTOK / 64; blk += gridDim.x) {
        const int b = (blk * 64) / SEQ;
        if (tid < 96) { const int idx = blk * 96 + tid; mod[idx] = mod_reduce(C, idx / (6 * DM), idx % (6 * DM)); }
#pragma unroll
        for (int i = 0; i < 4; ++i) { const int j = tid + 512 * i; shs[j] = mod_reduce(C, b, j); }
        __syncthreads();
        for (int hf = 0; hf < 2; ++hf) {
            const int row0 = blk * 64 + wv * 8 + hf * 4; f32x4 v[4][4];
#pragma unroll
            for (int i = 0; i < 4; ++i)
#pragma unroll
                for (int j = 0; j < 4; ++j) v[i][j] = ((const f32x4*)(C.x + (size_t)(row0 + i) * DM))[lane + 64 * j];
            f32x4 gs[4], sh[4];
#pragma unroll
            for (int j = 0; j < 4; ++j) { const int col = 4 * lane + 256 * j; gs[j] = *(const f32x4*)(C.g_mix + col) * (*(const LAS f32x4*)(shs + DM + col) + 1.f); sh[j] = *(const LAS f32x4*)(shs + col); }
#pragma unroll
            for (int i = 0; i < 4; ++i) { float ss = 0.f;
#pragma unroll
                for (int j = 0; j < 4; ++j) ss += v[i][j].x * v[i][j].x + v[i][j].y * v[i][j].y + v[i][j].z * v[i][j].z + v[i][j].w * v[i][j].w;
                const float rstd = rsqrtf(wave_sum(ss) * (1.f / DM) + EPS); float am = 0.f;
#pragma unroll
                for (int j = 0; j < 4; ++j) { v[i][j] = v[i][j] * rstd * gs[j] + sh[j]; const f32x4 a = __builtin_elementwise_abs(v[i][j]); am = fmaxf(fmaxf(am, fmaxf(a.x, a.y)), fmaxf(a.z, a.w)); }
                am = wave_max(am); const float inv = am > 0.f ? 127.f / am : 0.f;
#pragma unroll
                for (int j = 0; j < 4; ++j) *(unsigned*)(H8 + (size_t)(row0 + i) * DM + 4 * lane + 256 * j) = pack_q8(v[i][j].x, v[i][j].y, v[i][j].z, v[i][j].w, inv);
                if (lane == 0) sa[row0 + i] = am * (1.f / 127.f); }
        }
        __syncthreads();
    }
}
typedef float rt_f32x16 __attribute__((ext_vector_type(16)));
__device__ __forceinline__ void phase_route(CtxK& C, LAS unsigned char* lds) {
    LAS int* sel = (LAS int*)(lds + L_SEL);
    const int tid = hid_tid(), lane = tid & 63, wv = tid >> 6;
    LAS unsigned char* hb = lds + RING_OFF;
    LAS float* hs = (LAS float*)(lds + RING_OFF);
    const bf16_t* X1 = WSP(bf16_t, WS_X1); const float* mod = WSP(float, WS_MOD); unsigned char* H8F = WSP(unsigned char, WS_H8F); float* saf = WSP(float, WS_SAF);
    int* tope = WSP(int, WS_TOPE); float* topw = WSP(float, WS_TOPW); int* lrank = WSP(int, WS_LRANK); int* hist = WSP(int, WS_HIST);
    for (int g = blockIdx.x; g < NGRP; g += gridDim.x) {
        bf16x8 wf[8];
        { const bf16_t* wt = WSP(bf16_t, WS_WRT) + (size_t)(lane & 31) * DM + wv * 128 + 8 * (lane >> 5);
#pragma unroll
            for (int ks = 0; ks < 8; ++ks) wf[ks] = *(const bf16x8*)(wt + 16 * ks); }
        for (int ps = 0; ps < 2; ++ps) {
            { const int t0 = g * 64 + wv * 8 + ps * 4, b = t0 / SEQ;
                f32x4 v[4][4], g4[4], sh[4], sc[4];
#pragma unroll
                for (int i = 0; i < 4; ++i)
#pragma unroll
                    for (int j = 0; j < 4; ++j) { const f32x2 raw = ((const f32x2*)(X1 + (size_t)(t0 + i) * DM))[lane + 64 * j]; const unsigned u0 = __float_as_uint(raw.x), u1 = __float_as_uint(raw.y);
                        v[i][j] = (f32x4){__uint_as_float(u0 << 16), __uint_as_float(u0 & 0xffff0000u), __uint_as_float(u1 << 16), __uint_as_float(u1 & 0xffff0000u)}; }
#pragma unroll
                for (int j = 0; j < 4; ++j) { const int col = 4 * lane + 256 * j; g4[j] = *(const f32x4*)(C.g_ffn + col);
                    sh[j] = *(const f32x4*)(mod + b * 6 * DM + 3 * DM + col); sc[j] = *(const f32x4*)(mod + b * 6 * DM + 4 * DM + col); g4[j] = g4[j] * (sc[j] + 1.f); }
#pragma unroll
                for (int i = 0; i < 4; ++i) { float ss = 0.f;
#pragma unroll
                    for (int j = 0; j < 4; ++j) ss += v[i][j].x * v[i][j].x + v[i][j].y * v[i][j].y + v[i][j].z * v[i][j].z + v[i][j].w * v[i][j].w;
                    const float rstd = rsqrtf(wave_sum(ss) * (1.f / DM) + EPS);
                    const int tl = wv * 8 + ps * 4 + i;
                    float am = 0.f;
#pragma unroll
                    for (int j = 0; j < 4; ++j) {
                        const f32x4 y = v[i][j] * rstd * g4[j] + sh[j]; v[i][j] = y;
                        f32x2 pk; pk.x = __uint_as_float(pg8::cvt_pk_bf16(y.x, y.y)); pk.y = __uint_as_float(pg8::cvt_pk_bf16(y.z, y.w));
                        *(LAS f32x2*)(hb + tl * 2048 + (((((lane >> 1) + 32 * j)) ^ (tl & 15)) << 4) + (lane & 1) * 8) = pk;
                        const f32x4 a = __builtin_elementwise_abs(y); am = fmaxf(fmaxf(am, fmaxf(a.x, a.y)), fmaxf(a.z, a.w)); }
                    am = wave_max(am); const float inv = am > 0.f ? 127.f / am : 0.f;
#pragma unroll
                    for (int j = 0; j < 4; ++j) *(unsigned*)(H8F + (size_t)(t0 + i) * DM + 4 * lane + 256 * j) = pack_q8(v[i][j].x, v[i][j].y, v[i][j].z, v[i][j].w, inv);
                    if (lane == 0) saf[t0 + i] = am * (1.f / 127.f); }
            }
        }
        __syncthreads();
        rt_f32x16 acc0, acc1;
#pragma unroll
        for (int r = 0; r < 16; ++r) { acc0[r] = 0.f; acc1[r] = 0.f; }
        { const int tk = lane & 31, sw = tk & 15; const LAS unsigned char* ha = hb + tk * 2048;
#pragma unroll
            for (int ks = 0; ks < 8; ++ks) { const int c = wv * 16 + 2 * ks + (lane >> 5);
                const bf16x8 a0 = *(const LAS bf16x8*)(ha + ((c ^ sw) << 4)), a1 = *(const LAS bf16x8*)(ha + 32 * 2048 + ((c ^ sw) << 4));
                acc0 = __builtin_amdgcn_mfma_f32_32x32x16_bf16(a0, wf[ks], acc0, 0, 0, 0); acc1 = __builtin_amdgcn_mfma_f32_32x32x16_bf16(a1, wf[ks], acc1, 0, 0, 0); } }
        __syncthreads();
        { LAS float* pp = hs + wv * 2048 + (lane & 31);
#pragma unroll
            for (int r = 0; r < 16; ++r) { const int tk = (r & 3) + 8 * (r >> 2) + 4 * (lane >> 5); pp[tk * 32] = acc0[r]; pp[(32 + tk) * 32] = acc1[r]; } }
        __syncthreads();
        { const int l2 = hid_tid() & 63, e = l2 & 31, hf = l2 >> 5; const float br = C.b_router[e];
            LAS float* fin = (LAS float*)(lds + RING_OFF + 65536) + wv * 256;
            LAS float* tkv = (LAS float*)(lds + RING_OFF + 65536 + 8192) + wv * 64;
#pragma unroll
            for (int pi = 0; pi < 4; ++pi) {
                const int q = 2 * pi + hf, tp = wv * 8 + q;
                float lg = br;
#pragma unroll
                for (int w8 = 0; w8 < 8; ++w8) lg += hs[w8 * 2048 + tp * 32 + e];
                fin[q * 32 + e] = lg;
            }
            __builtin_amdgcn_wave_barrier();
#pragma unroll
            for (int pi = 0; pi < 4; ++pi) {
                const int q = 2 * pi + hf; const float mine = fin[q * 32 + e]; int rank = 0;
#pragma unroll
                for (int j4 = 0; j4 < 8; ++j4) { const f32x4 o = *(const LAS f32x4*)(fin + q * 32 + 4 * j4);
#pragma unroll
                    for (int c = 0; c < 4; ++c) { const int j = 4 * j4 + c; rank += (o[c] > mine || (o[c] == mine && j < e)) ? 1 : 0; } }
                if (rank < 4) { tkv[q * 4 + rank] = mine; ((LAS int*)tkv)[32 + q * 4 + rank] = e; }
            }
            __builtin_amdgcn_wave_barrier();
            if (l2 < 32) { const int q = l2 >> 2, k = l2 & 3, tl = wv * 8 + q, t = g * 64 + tl;
                const f32x4 tv = *(const LAS f32x4*)(tkv + q * 4); const int ei = ((const LAS int*)tkv)[32 + q * 4 + k] & (NE - 1);
                const float e0 = 1.f, e1 = expf(tv[1] - tv[0]), e2 = expf(tv[2] - tv[0]), e3 = expf(tv[3] - tv[0]); const float es = ((e0 + e1) + e2) + e3;
                const float mine = (k == 0) ? e0 : (k == 1) ? e1 : (k == 2) ? e2 : e3;
                tope[t * 4 + k] = ei; topw[t * 4 + k] = mine / es; sel[tl * 4 + k] = ei; }
        }
        __syncthreads();
        if (tid < 256) { const int tl = tid >> 2, k = tid & 3, e = sel[tl * 4 + k]; int r = 0;
            for (int q = 0; q < tl; ++q) r += (sel[q * 4] == e) + (sel[q * 4 + 1] == e) + (sel[q * 4 + 2] == e) + (sel[q * 4 + 3] == e);
            lrank[(g * 64 + tl) * 4 + k] = r;
        } else if (tid < 256 + NE) { const int e = tid - 256; int r = 0;
            for (int q = 0; q < 64; ++q) r += (sel[q * 4] == e) + (sel[q * 4 + 1] == e) + (sel[q * 4 + 2] == e) + (sel[q * 4 + 3] == e);
            hist[g * NE + e] = r; }
        __syncthreads();
    }
}
__device__ __forceinline__ void phase_slots(CtxK& C, LAS unsigned char* lds) {
    const int tid = hid_tid();
    const int* hist = WSP(int, WS_HIST); const int* tope = WSP(int, WS_TOPE); const float* topw = WSP(float, WS_TOPW); const int* lrank = WSP(int, WS_LRANK);
    int* pos = WSP(int, WS_POS); int* tokslot = WSP(int, WS_TOKSLOT); float* wslot = WSP(float, WS_WSLOT); float* sas = WSP(float, WS_SAS); const float* saf = WSP(float, WS_SAF);
    moe_tables(hist, lds);
    const LAS int* poff = (const LAS int*)(lds + L_POFF); const LAS int* part = (const LAS int*)(lds + L_PART); LAS int* goff = (LAS int*)(lds + L_GOFF);
    for (int g = blockIdx.x; g < NGRP; g += gridDim.x) {
        if (tid < NE) { int s = poff[tid]; const int pb = g >> 4;
            for (int p = 0; p < pb; ++p) s += part[p * NE + tid];
            for (int q = pb * 16; q < g; ++q) s += hist[q * NE + tid];
            goff[tid] = s; }
        __syncthreads();
        if (tid < 256) { const int idx = (g * 64 + (tid >> 2)) * 4 + (tid & 3); const int e = tope[idx]; const int slot = goff[e] + lrank[idx];
            pos[idx] = slot; tokslot[slot] = g * 64 + (tid >> 2); wslot[slot] = topw[idx]; sas[slot] = saf[g * 64 + (tid >> 2)]; }
        __syncthreads();
    }
}
__device__ __forceinline__ void phase_final(CtxK& C, int gw, int ngw, int lane) {
    const bf16_t* X1 = WSP(bf16_t, WS_X1); const float* mod = WSP(float, WS_MOD); const unsigned char* Y = WSP(unsigned char, WS_Y); const int* pos = WSP(int, WS_POS); const float* topw = WSP(float, WS_TOPW);
    constexpr int U = 4;
    for (int r0 = gw; r0 < NTOK; r0 += U * ngw) {
        int p[U][4]; float wk[U][4];
#pragma unroll
        for (int u = 0; u < U; ++u) { const int row = (r0 + u * ngw < NTOK) ? r0 + u * ngw : r0;
#pragma unroll
            for (int k = 0; k < 4; ++k) { p[u][k] = pos[row * 4 + k]; wk[u][k] = topw[row * 4 + k]; } }
        int yy[U][4][4]; f32x2 raw[U][4];
#pragma unroll
        for (int u = 0; u < U; ++u) { const int row = (r0 + u * ngw < NTOK) ? r0 + u * ngw : r0;
#pragma unroll
            for (int j = 0; j < 4; ++j) { const int col = 4 * lane + 256 * j;
#pragma unroll
                for (int k = 0; k < 4; ++k) yy[u][j][k] = *(const int*)(Y + (size_t)p[u][k] * DM + col);
                raw[u][j] = *(const f32x2*)(X1 + (size_t)row * DM + col); } }
#pragma unroll
        for (int u = 0; u < U; ++u) { const int row = r0 + u * ngw; if (row < NTOK) {
            const int b = row / SEQ; f32x4 v[4]; float ss = 0.f;
#pragma unroll
            for (int j = 0; j < 4; ++j) { const int col = 4 * lane + 256 * j; f32x4 f = {0.f, 0.f, 0.f, 0.f};
#pragma unroll
                for (int k = 0; k < 4; ++k) { const f32x2 lo = __builtin_amdgcn_cvt_pk_f32_fp8(yy[u][j][k], false), hi = __builtin_amdgcn_cvt_pk_f32_fp8(yy[u][j][k], true);
                    f.x += wk[u][k] * lo.x; f.y += wk[u][k] * lo.y; f.z += wk[u][k] * hi.x; f.w += wk[u][k] * hi.y; }
                const f32x4 gt = *(const f32x4*)(mod + b * 6 * DM + 5 * DM + col);
                const unsigned u0 = __float_as_uint(raw[u][j].x), u1 = __float_as_uint(raw[u][j].y);
                v[j] = (f32x4){__uint_as_float(u0 << 16), __uint_as_float(u0 & 0xffff0000u), __uint_as_float(u1 << 16), __uint_as_float(u1 & 0xffff0000u)} + gt * f; ss += v[j].x * v[j].x + v[j].y * v[j].y + v[j].z * v[j].z + v[j].w * v[j].w; }
            const float rstd = rsqrtf(wave_sum(ss) * (1.f / DM) + EPS);
#pragma unroll
            for (int j = 0; j < 4; ++j) { const int col = 4 * lane + 256 * j; *(f32x4*)(C.out + (size_t)row * DM + col) = v[j] * rstd * *(const f32x4*)(C.g_final + col); }
        } }
    }
}

constexpr int N_PHASES = 11;
__global__ void __launch_bounds__(NWAVES * 64, 2) mega_fwd(Ctx Carg) {
    extern __shared__ __attribute__((aligned(16))) unsigned char lds_raw[];
    LAS unsigned char* lds = (LAS unsigned char*)lds_raw;
#define TZ() ({ int tz_ = threadIdx.x; asm volatile("" : "+v"(tz_)); tz_; })
#define WV(t) __builtin_amdgcn_readfirstlane((t) >> 6)
    { const int t0 = TZ(); for (int u = t0; u < (LDS_BYTES - LCTL_OFF) / 4; u += NWAVES * 64) ((LAS unsigned*)(lds + LCTL_OFF))[u] = 0u; }
    __syncthreads();
    const int ngw = gridDim.x * NWAVES;
    XcdBarrier bar = xcd_barrier_post((unsigned*)(Carg.ws + WS_CTL) + CW_BAR, (volatile LAS unsigned*)(lds + L_BARW));
    const int lo = Carg.ph_lo, hi = Carg.ph_hi;
#define C (*ctx_here())
#define IN(k) (lo <= (k) && (k) < hi)
#define SEAM(k) do { if (IN(k) && IN((k) + 1)) { xcd_barrier(bar); if (PROBE_DBL & 2048) xcd_barrier(bar); } } while (0)
    for (int rep_ = 0; rep_ < ((PROBE_DBL & 1) ? 2 : 1); ++rep_) if (IN(0)) { { const int t = TZ(); phase_weights(C, lds, blockIdx.x * NWAVES + WV(t), ngw, WV(t), t & 63); }
                 { const int t = TZ(); phase_mod_partials(C, blockIdx.x * NWAVES + WV(t), ngw, t & 63); }
                 { const int t = TZ(); phase_rope_misc(C, blockIdx.x * (NWAVES * 64) + t, gridDim.x * (NWAVES * 64)); } }
    SEAM(0);
    for (int rep_ = 0; rep_ < ((PROBE_DBL & 2) ? 2 : 1); ++rep_) if (IN(1)) { phase_norm1(C, lds); { const int t = TZ(); phase_quant_win(C, blockIdx.x * NWAVES + WV(t), ngw, t & 63); } }
    SEAM(1);
    for (int rep_ = 0; rep_ < ((PROBE_DBL & 4) ? 2 : 1); ++rep_) if (IN(2)) phase_proj(C, lds);
    SEAM(2);
    for (int rep_ = 0; rep_ < ((PROBE_DBL & 8) ? 2 : 1); ++rep_) if (IN(3)) phase_attn(C, lds_raw, lds, CW_QB + 256 * rep_, CW_QA + 256 * rep_, CW_QC + 256 * rep_);
    SEAM(3);
    for (int rep_ = 0; rep_ < ((PROBE_DBL & 16) ? 2 : 1); ++rep_) if (IN(4)) { const int t = TZ(); phase_combine(C, blockIdx.x * NWAVES + WV(t), ngw, t & 63); }
    SEAM(4);
    for (int rep_ = 0; rep_ < ((PROBE_DBL & 32) ? 2 : 1); ++rep_) if (IN(5)) phase_out(C, lds);
    SEAM(5);
    for (int rep_ = 0; rep_ < ((PROBE_DBL & 64) ? 2 : 1); ++rep_) if (IN(6)) phase_route(C, lds);
    SEAM(6);
    for (int rep_ = 0; rep_ < ((PROBE_DBL & 128) ? 2 : 1); ++rep_) if (IN(7)) phase_slots(C, lds);
    SEAM(7);
    int mx_X = 0, mx_Y = 0, mx_nx = 0; bool mixed = false;
    if (IN(8)) { if (!IN(7)) moe_tables(WSP(int, WS_HIST), lds);
        const int ntile = ((const LAS int*)(lds + L_POFF))[NE] >> 8;
        mixed = ((int)gridDim.x == 256) && IN(9) && ntile >= 256; mx_X = mixed ? 256 : ntile;
        if (mixed) { const int L = ntile - 256; mx_nx = (L + 3) >> 2; if (mx_nx > 8) mx_nx = 8; mx_Y = 192 + 8 * (8 - mx_nx); }
        phase_gate_up(C, lds, 0, mx_X, 0); }
    SEAM(8);
    if (IN(9)) { if (!IN(7)) moe_tables(WSP(int, WS_HIST), lds);
        const int ntile = ((const LAS int*)(lds + L_POFF))[NE] >> 8;
        if (mixed) { phase_gate_up(C, lds, mx_X, ntile, 0); phase_down(C, lds, 0, mx_Y, mx_nx); xcd_barrier(bar); phase_down(C, lds, mx_Y, ntile, 0); }
        else phase_down(C, lds, 0, ntile, 0); }
    SEAM(9);
    for (int rep_ = 0; rep_ < ((PROBE_DBL & 1024) ? 2 : 1); ++rep_) if (IN(10)) { const int t = TZ(); phase_final(C, blockIdx.x * NWAVES + WV(t), ngw, t & 63); }
#undef C
#undef IN
#undef SEAM
#undef TZ
#undef WV
}

#ifndef MK_N_LAUNCHES
#define MK_N_LAUNCHES 1
#endif
extern "C" void kernel_launch(void* const* d_in, const int* in_sizes, int n_in, void* d_out, int out_size, void* d_ws, size_t ws_size, hipStream_t stream) {
    static int grid = 0;
    if (grid == 0) {
        if (n_in != 22 || ws_size < WS_END) { grid = -1; return; }
        int dev = 0, cus = 0;
        if (hipGetDevice(&dev) != hipSuccess || hipDeviceGetAttribute(&cus, hipDeviceAttributeMultiprocessorCount, dev) != hipSuccess || cus <= 0) { grid = -1; return; }
        if (hipFuncSetAttribute((const void*)mega_fwd, hipFuncAttributeMaxDynamicSharedMemorySize, LDS_BYTES) != hipSuccess) { grid = -1; return; }
        int per_cu = 0;
        if (hipOccupancyMaxActiveBlocksPerMultiprocessor(&per_cu, (const void*)mega_fwd, NWAVES * 64, LDS_BYTES) != hipSuccess || per_cu < 1) { (void)hipGetLastError(); }
        grid = cus;
    }
    if (grid < 0) return;
    (void)hipMemsetAsync((char*)d_ws + WS_CTL, 0, CTL_ZERO_BYTES, stream);
    Ctx C{};
    C.x = (const float*)d_in[0]; C.c = (const float*)d_in[1]; C.positions = (const int*)d_in[2]; C.w_ada = (const float*)d_in[3]; C.b_ada = (const float*)d_in[4];
    C.g_mix = (const float*)d_in[5]; C.w_in = (const float*)d_in[6]; C.rel_bias = (const float*)d_in[7]; C.lq1 = (const float*)d_in[8]; C.lk1 = (const float*)d_in[9];
    C.lq2 = (const float*)d_in[10]; C.lk2 = (const float*)d_in[11]; C.g_subln = (const float*)d_in[12]; C.w_out = (const float*)d_in[13]; C.g_ffn = (const float*)d_in[14];
    C.w_router = (const float*)d_in[15]; C.b_router = (const float*)d_in[16]; C.w_gate_up = (const float*)d_in[17]; C.b_gate_up = (const float*)d_in[18];
    C.w_down = (const float*)d_in[19]; C.b_down = (const float*)d_in[20]; C.g_final = (const float*)d_in[21];
    C.out = (float*)d_out; C.ws = (unsigned char*)d_ws;
    if (MK_N_LAUNCHES == 1) { C.ph_lo = 0; C.ph_hi = N_PHASES; hipLaunchKernelGGL(mega_fwd, dim3(grid), dim3(NWAVES * 64), LDS_BYTES, stream, C); }
    else for (int p = 0; p < N_PHASES; ++p) { C.ph_lo = p; C.ph_hi = p + 1; hipLaunchKernelGGL(mega_fwd, dim3(grid), dim3(NWAVES * 64), LDS_BYTES, stream, C); }
}
```

```cpp
#include <hip/hip_runtime.h>
#include <hip/hip_bf16.h>
#include <stdint.h>
#include <math.h>

#define PROBE_DBL 0
typedef unsigned short bf16_t;
typedef float f32x4 __attribute__((ext_vector_type(4)));

constexpr int NB = 4, SEQ = 4096, DM = 1024, NTOK = NB * SEQ;
constexpr int INW = 3072;
constexpr int NE = 32, TOPK = 4;
constexpr int NSLOT_MAX = NTOK * TOPK + NE * 256;
constexpr int NGRP = 256;
constexpr float EPS = 1e-6f;
constexpr float LOG2E = 1.4426950408889634f;
constexpr float C2 = 0.125f * LOG2E;
constexpr float LAMBDA_INIT = 0.2f;
constexpr int COL_QA = 0, COL_KA = 512, COL_VA = 1024, COL_QB = 1536, COL_KB = 2048, COL_VB = 2560;
constexpr int MODP_KC = 16;

constexpr size_t MiB = 1u << 20;
constexpr size_t WS_CTL = 0, WS_MOD = 1 * MiB, WS_ROPE = 2 * MiB, WS_TOPE = 4 * MiB, WS_TOPW = 5 * MiB, WS_LRANK = 6 * MiB, WS_POS = 7 * MiB,
                 WS_HIST = 8 * MiB, WS_TOKSLOT = 9 * MiB, WS_WSLOT = 10 * MiB, WS_SA = 11 * MiB, WS_SBIN = 11 * MiB + 512 * 1024, WS_MODP = 12 * MiB, WS_WIN_T = 16 * MiB, WS_WOUT_T = 22 * MiB, WS_WGU_T = 32 * MiB,
                 WS_WD_T = 160 * MiB, WS_H = 224 * MiB, WS_PQ = 256 * MiB, WS_OC = 352 * MiB, WS_MIX = 384 * MiB, WS_X1 = 416 * MiB,
                 WS_ACT = 480 * MiB, WS_Y = 624 * MiB, WS_H8 = 768 * MiB, WS_WIN8 = 784 * MiB, WS_SBGU = 788 * MiB, WS_CMAXGU = 789 * MiB, WS_SAF = 790 * MiB, WS_SAS = 791 * MiB, WS_END = 792 * MiB;
constexpr size_t WS_WRT = WS_TOPE + 512 * 1024;
constexpr size_t WS_MIX8 = WS_PQ, WS_SAM = WS_PQ + 32 * MiB;
constexpr size_t WS_WOUT8 = WS_WOUT_T, WS_SBOUT = WS_SBIN + 16384;
constexpr size_t WS_WD8 = WS_WD_T, WS_SBD = WS_CMAXGU;
constexpr size_t WS_H8F = WS_H, WS_WGU8 = WS_WGU_T;
constexpr size_t CTL_ZERO_BYTES = 64 * 1024;
constexpr int CW_QB = 64, CW_QA = 128, CW_QC = 192, CW_BAR = 1024, CW_CMAX_IN = 8192;

struct Ctx {
    const float *x, *c; const int* positions; const float *w_ada, *b_ada, *g_mix, *w_in, *rel_bias, *lq1, *lk1, *lq2, *lk2, *g_subln, *w_out, *g_ffn,
        *w_router, *b_router, *w_gate_up, *b_gate_up, *w_down, *b_down, *g_final;
    float* out; unsigned char* ws; int ph_lo, ph_hi;
};
typedef const __attribute__((address_space(4))) Ctx CtxK;
__device__ __forceinline__ CtxK* ctx_here() { unsigned long long v = (unsigned long long)__builtin_amdgcn_kernarg_segment_ptr(); asm volatile("" : "+s"(v)); return (CtxK*)v; }
#define WSP(T, off) ((T*)(C.ws + (off)))

__device__ __forceinline__ int hid_tid() { int t = threadIdx.x; asm volatile("" : "+v"(t)); return t; }
__device__ __forceinline__ float bf2f(bf16_t v) { return __uint_as_float(((unsigned)v) << 16); }
__device__ __forceinline__ bf16_t f2bf(float f) { unsigned u = __float_as_uint(f); return (bf16_t)((u + 0x7fffu + ((u >> 16) & 1u)) >> 16); }
template <int N> __device__ __forceinline__ float row_ror(float v) { return __int_as_float(__builtin_amdgcn_update_dpp(0, __float_as_int(v), 0x120 + N, 0xf, 0xf, false)); }
__device__ __forceinline__ void swap16(float v, float& even_rows, float& odd_rows) { const auto r = __builtin_amdgcn_permlane16_swap(__float_as_uint(v), __float_as_uint(v), false, false); even_rows = __uint_as_float(r[0]); odd_rows = __uint_as_float(r[1]); }
__device__ __forceinline__ void swap32(float v, float& lo_half, float& hi_half) { const auto r = __builtin_amdgcn_permlane32_swap(__float_as_uint(v), __float_as_uint(v), false, false); lo_half = __uint_as_float(r[0]); hi_half = __uint_as_float(r[1]); }
__device__ __forceinline__ float xor16(float v, int lane) { float a, b; swap16(v, a, b); return (lane & 16) ? a : b; }
__device__ __forceinline__ float row_sum(float v) { v += row_ror<1>(v); v += row_ror<2>(v); v += row_ror<4>(v); v += row_ror<8>(v); return v; }
__device__ __forceinline__ float wave_sum(float v) {
    v = row_sum(v); float a, b; swap16(v, a, b); v = a + b; swap32(v, a, b); return a + b;
}
__device__ __forceinline__ float rows_max(float v) { float a, b; swap16(v, a, b); v = fmaxf(a, b); swap32(v, a, b); return fmaxf(a, b); }
__device__ __forceinline__ float wave_max(float v) {
    v = fmaxf(v, row_ror<1>(v)); v = fmaxf(v, row_ror<2>(v)); v = fmaxf(v, row_ror<4>(v)); v = fmaxf(v, row_ror<8>(v)); return rows_max(v);
}

constexpr int RING_OFF = 0, RING_BYTES = 131072;
constexpr int LCTL_OFF = RING_BYTES;
constexpr int L_POFF = LCTL_OFF, L_TOT = L_POFF + 40 * 4, L_TILEE = L_TOT + 32 * 4, L_MISC = L_TILEE + 320 * 4, L_BARW = L_MISC + 64, L_PART = L_BARW + 64, L_SEL = L_PART + 16 * 32 * 4, L_GOFF = L_SEL + 1024, L_LG = L_GOFF + 128, L_TK = L_LG + 8 * 128 * 4, L_EP = L_TK + 8 * 32 * 4, L_END = L_EP + 2 * 3072;
constexpr int LDS_BYTES = 147456;
static_assert(L_END <= LDS_BYTES, "LDS map");
constexpr int NWAVES = 8;
#define LAS __attribute__((address_space(3)))
typedef short bf16x8 __attribute__((ext_vector_type(8)));
typedef unsigned u32x4 __attribute__((ext_vector_type(4)));
__device__ __forceinline__ void st16_wt(void* p, u32x4 v) { asm volatile("global_store_dwordx4 %0, %1, off sc1\n\ts_nop 1" :: "v"(p), "v"(v) : "memory"); }
typedef float f32x2 __attribute__((ext_vector_type(2)));
typedef int i32x4 __attribute__((ext_vector_type(4)));
typedef int i32x8 __attribute__((ext_vector_type(8)));
namespace pg8 {
constexpr int BM = 256, BK = 64, HALF = 128, HTB = HALF * BK * 2  , STAGE_BYTES = 8 * HTB, NXCD = 8, WGM = 8, KD = 1024  ;
__device__ __forceinline__ int lds_byte(int r, int c) { const int st = (r >> 4) * 2 + (c >> 5), rr = r & 15, cc = c & 31, ob = rr * 64 + cc * 2; return st * 1024 + (ob ^ (((ob >> 9) & 1) << 5)); }
__device__ __forceinline__ void stage_rc(int b, int& R, int& C) { const int st = b / 1024, sb = b % 1024, swz = sb ^ (((sb >> 9) & 1) << 5); R = (st >> 1) * 16 + swz / 64; C = (st & 1) * 32 + (swz % 64) / 2; }
__device__ __forceinline__ int perm32(int rho) { const int n = rho >> 4, i = rho & 15; return 8 * (i >> 2) + 4 * n + (i & 3); }
__device__ __forceinline__ void glds16s(const char* sbase, unsigned voff, unsigned lds_dst) { unsigned keep;
    asm volatile("s_mov_b32 %0, m0\n\ts_mov_b32 m0, %3\n\ts_nop 0\n\tglobal_load_lds_dwordx4 %1, %2\n\ts_mov_b32 m0, %0" : "=&s"(keep) : "v"(voff), "s"(sbase), "s"(lds_dst) : "memory"); }
template <int IMM> __device__ __forceinline__ void glds16i(const char* sbase, unsigned voff, unsigned lds_base) { unsigned keep;
    asm volatile("s_mov_b32 %0, m0\n\ts_add_i32 m0, %3, %4\n\ts_nop 0\n\tglobal_load_lds_dwordx4 %1, %2\n\ts_mov_b32 m0, %0" : "=&s"(keep) : "v"(voff), "s"(sbase), "s"(lds_base), "n"(IMM) : "memory", "scc"); }
struct Unit { int pm, pn, e; };
__device__ __forceinline__ unsigned cvt_pk_bf16(float lo, float hi) { unsigned r; asm volatile("v_cvt_pk_bf16_f32 %0, %1, %2" : "=v"(r) : "v"(lo), "v"(hi)); return r; }

template <int KB_> struct ProbDense {
    static constexpr bool GATHER_A = false; static constexpr int KB = KB_, DT = (KB_ == 1024) ? 1 : 0;
    const char* A; const char* Bt; int nM, nN, nwg, G, c;
    __device__ __forceinline__ void init(const void* A_, const void* Bt_, int M, int N, int G_, int c_) { A = (const char*)A_; Bt = (const char*)Bt_; nM = M / BM; nN = N / BM; nwg = nM * nN; G = G_; c = c_; }
    __device__ __forceinline__ bool next(int i, Unit& u) const {
        const long L = (long)i * G + c; if (L >= nwg) return false;
        int wgid = (int)L; { const int q = nwg / NXCD, r = nwg % NXCD, xcd = wgid % NXCD, off = wgid / NXCD; wgid = (xcd < r ? xcd * (q + 1) : r * (q + 1) + (xcd - r) * q) + off; }
        const int nig = WGM * nN, gid = wgid / nig, fm = gid * WGM, gsz = (nM - fm) < WGM ? (nM - fm) : WGM;
        u.pm = fm + ((wgid % nig) % gsz); u.pn = (wgid % nig) / gsz; u.e = 0; return true;
    }
    __device__ __forceinline__ const char* a_base(const Unit& u) const { return A + (size_t)u.pm * (BM * KB); }
    __device__ __forceinline__ const char* b_base(const Unit& u) const { return Bt + (size_t)u.pn * (BM * KB); }
    __device__ __forceinline__ void a_voff(const Unit&, unsigned (&v)[2][2], const int (&R)[2], const int (&C)[2]) const {
#pragma unroll
        for (int h = 0; h < 2; ++h)
#pragma unroll
            for (int i = 0; i < 2; ++i) v[h][i] = (unsigned)((h * HALF + R[i]) * KB + 2 * C[i]);
    }
};
template <bool GATHER, int KB_, int DT_ = (KB_ == 1024 ? 1 : 0)> struct ProbMoE {
    static constexpr bool GATHER_A = GATHER; static constexpr int KB = KB_, DT = DT_;
    const char* A; const char* Bt; const int* tokslot; const LAS int* tile_e; int ntile, nN, G, c, t0, xrot;
    __device__ __forceinline__ bool next(int i, Unit& u) const {
        if ((G & 7) == 0 && ((G >> 3) % nN) == 0) { const int per = (G >> 3) / nN, x = ((c & 7) - xrot) & 7, j = c >> 3; u.pm = t0 + (i * 8 + x) * per + j / nN; u.pn = j % nN; if (u.pm >= ntile) return false; }
        else { const int L = i * G + c; u.pm = t0 + L / nN; u.pn = L % nN; if (u.pm >= ntile) return false; }
        u.e = __builtin_amdgcn_readfirstlane(tile_e[u.pm]); return true;
    }
    __device__ __forceinline__ const char* a_base(const Unit& u) const { return GATHER ? A : A + (size_t)u.pm * (BM * KB); }
    __device__ __forceinline__ const char* b_base(const Unit& u) const { return Bt + ((size_t)u.e * nN + u.pn) * (size_t)(BM * KB); }
    __device__ __forceinline__ void a_voff(const Unit& u, unsigned (&v)[2][2], const int (&R)[2], const int (&C)[2]) const {
#pragma unroll
        for (int h = 0; h < 2; ++h)
#pragma unroll
            for (int i = 0; i < 2; ++i) { int tz = threadIdx.x; asm volatile("" : "+v"(tz)); int Rz, Cz; stage_rc(tz * 16 + i * 8192, Rz, Cz);
                const int row = GATHER ? tokslot[u.pm * BM + h * HALF + Rz] : (h * HALF + Rz);
                if (GATHER) { if (i == 0) v[h][0] = (unsigned)row; else { v[h][0] |= (unsigned)row << 16; v[h][1] = 0u; } } else v[h][i] = (unsigned)(row * KB + 2 * Cz); }
    }
};

struct EpiProj {
    static constexpr bool PERM = true, PREF = false;
    bf16_t* PQ; const float* rope; const float* sa; const float* sb;
    __device__ __forceinline__ void operator()(f32x4 (&acc)[2][2][4][2], const Unit& u, int wr, int wc, int fr, int fq) const {
        const int row0 = u.pm * BM + wr * 64 + fr;
#pragma unroll
        for (int bj = 0; bj < 2; ++bj) { const float* sp = sb + u.pn * BM + bj * HALF + wc * 32 + 8 * fq; const f32x4 s0 = *(const f32x4*)sp, s1 = *(const f32x4*)(sp + 4);
#pragma unroll
            for (int ai = 0; ai < 2; ++ai)
#pragma unroll
                for (int m = 0; m < 4; ++m) { const float ra = sa[row0 + ai * HALF + m * 16]; acc[ai][bj][m][0] = acc[ai][bj][m][0] * (s0 * ra); acc[ai][bj][m][1] = acc[ai][bj][m][1] * (s1 * ra); } }
#pragma unroll
        for (int bj = 0; bj < 2; ++bj) {
            const int colb = u.pn * BM + bj * HALF + wc * 32;
            const float sc = (colb < COL_KA || (colb >= COL_QB && colb < COL_KB)) ? C2 : 1.f;
            if (colb >= COL_QB && colb < COL_VB && (colb & 32) == 0) {
                const float sg = (fq == 0) ? -1.f : ((fq == 1) ? 1.f : 0.f); const bool rl = fq < 2;
#pragma unroll
                for (int ai = 0; ai < 2; ++ai)
#pragma unroll
                    for (int m = 0; m < 4; ++m) {
                        const f32x4* rp = (const f32x4*)(rope + (size_t)(row0 + ai * HALF + m * 16) * 16);
#pragma unroll
                        for (int n = 0; n < 2; ++n) { const f32x4 ra = rp[2 * n], rb = rp[2 * n + 1]; f32x4 v = acc[ai][bj][m][n], p;
#pragma unroll
                            for (int j = 0; j < 4; ++j) p[j] = xor16(v[j], fq * 16);
                            v[0] = v[0] * (rl ? ra[0] : 1.f) + sg * p[0] * ra[1]; v[1] = v[1] * (rl ? ra[2] : 1.f) + sg * p[1] * ra[3];
                            v[2] = v[2] * (rl ? rb[0] : 1.f) + sg * p[2] * rb[1]; v[3] = v[3] * (rl ? rb[2] : 1.f) + sg * p[3] * rb[3];
                            acc[ai][bj][m][n] = v; }
                        asm volatile("" : "+v"(acc[ai][bj][m][0]), "+v"(acc[ai][bj][m][1]) :: "memory");
                    }
            }
#pragma unroll
            for (int ai = 0; ai < 2; ++ai)
#pragma unroll
                for (int m = 0; m < 4; ++m) {
                    const int row = row0 + ai * HALF + m * 16;
                    const f32x4 v0 = acc[ai][bj][m][0] * sc, v1 = acc[ai][bj][m][1] * sc;
                    u32x4 w; w.x = cvt_pk_bf16(v0[0], v0[1]); w.y = cvt_pk_bf16(v0[2], v0[3]); w.z = cvt_pk_bf16(v1[0], v1[1]); w.w = cvt_pk_bf16(v1[2], v1[3]);
                    st16_wt(PQ + (size_t)row * INW + colb + 8 * fq, w);
                }
        }
    }
};
struct EpiOut {
    static constexpr bool PERM = true, PREF = false;
    const float* __restrict__ x; const float* __restrict__ mod; bf16_t* __restrict__ X1; const float* __restrict__ sa; const float* __restrict__ sb;
    __device__ __forceinline__ void operator()(const f32x4 (&acc)[2][2][4][2], const Unit& u, int wr, int wc, int fr, int fq) const {
        const int b = (u.pm * BM) / SEQ; const int col0 = u.pn * BM + wc * 32 + 8 * fq;
#pragma unroll
        for (int bj = 0; bj < 2; ++bj) { const int col = col0 + bj * HALF; const f32x4 g0 = *(const f32x4*)(mod + b * 6 * DM + 2 * DM + col) * *(const f32x4*)(sb + col), g1 = *(const f32x4*)(mod + b * 6 * DM + 2 * DM + col + 4) * *(const f32x4*)(sb + col + 4);
#pragma unroll
            for (int ai = 0; ai < 2; ++ai) { f32x4 xa[4], xb[4]; float ra[4];
#pragma unroll
                for (int m = 0; m < 4; ++m) { const size_t off = (size_t)(u.pm * BM + ai * HALF + wr * 64 + m * 16 + fr) * DM + col; xa[m] = *(const f32x4*)(x + off); xb[m] = *(const f32x4*)(x + off + 4); ra[m] = sa[u.pm * BM + ai * HALF + wr * 64 + m * 16 + fr]; }
#pragma unroll
                for (int m = 0; m < 4; ++m) { const size_t off = (size_t)(u.pm * BM + ai * HALF + wr * 64 + m * 16 + fr) * DM + col;
                    const f32x4 v0 = xa[m] + (g0 * ra[m]) * acc[ai][bj][m][0], v1 = xb[m] + (g1 * ra[m]) * acc[ai][bj][m][1];
                    u32x4 w; w.x = cvt_pk_bf16(v0[0], v0[1]); w.y = cvt_pk_bf16(v0[2], v0[3]); w.z = cvt_pk_bf16(v1[0], v1[1]); w.w = cvt_pk_bf16(v1[2], v1[3]);
                    *(u32x4*)(X1 + off) = w; } } }
    }
};
struct EpiGateUp {
    static constexpr bool PERM = true, PREF = true;
    unsigned char* ACT; const float* bgu; const float* sas; const float* sbgu;
    __device__ __forceinline__ void prefetch(const Unit& u, LAS unsigned char* lds, int wid, int, int par) const {
        int tz = threadIdx.x; asm volatile("" : "+v"(tz)); const int lane = tz & 63;
        const unsigned dst = (unsigned)(size_t)(lds + L_EP + par * 3072); const unsigned vo = (lane < 32) ? (unsigned)lane * 16u : (unsigned)(DM * 4 + (lane - 32) * 16);
        if (wid == 0) glds16s((const char*)(bgu + (size_t)u.e * 2 * DM + u.pn * HALF), vo, (unsigned)__builtin_amdgcn_readfirstlane((int)dst));
        else if (wid == 1) glds16s((const char*)(sbgu + (size_t)u.e * 2 * DM + u.pn * HALF), vo, (unsigned)__builtin_amdgcn_readfirstlane((int)(dst + 1024)));
    }
    __device__ __forceinline__ void run(const f32x4 (&acc)[2][2][4][2], const Unit& u, int wr, int wc, int fr, int fq, LAS unsigned char* lds, int par) const {
        const LAS float* ep = (const LAS float*)(lds + L_EP + par * 3072);
        const int j0 = u.pn * HALF + wc * 32 + 8 * fq, jl = wc * 32 + 8 * fq;
        const f32x4 bg0 = *(const LAS f32x4*)(ep + jl), bg1 = *(const LAS f32x4*)(ep + jl + 4), bu0 = *(const LAS f32x4*)(ep + 128 + jl), bu1 = *(const LAS f32x4*)(ep + 128 + jl + 4);
        const f32x4 sg0 = *(const LAS f32x4*)(ep + 256 + jl), sg1 = *(const LAS f32x4*)(ep + 256 + jl + 4), su0 = *(const LAS f32x4*)(ep + 384 + jl), su1 = *(const LAS f32x4*)(ep + 384 + jl + 4);
#pragma unroll
        for (int ai = 0; ai < 2; ++ai)
#pragma unroll
            for (int m = 0; m < 4; ++m) {
                const int rl = ai * HALF + wr * 64 + m * 16 + fr, row = u.pm * BM + rl;
                float o[8];
#pragma unroll
                for (int n = 0; n < 2; ++n) { const f32x4 ag = acc[ai][0][m][n], au = acc[ai][1][m][n], sg = n ? sg1 : sg0, su = n ? su1 : su0, bg = n ? bg1 : bg0, bu = n ? bu1 : bu0;
#pragma unroll
                    for (int h = 0; h < 2; ++h) {
                        const f32x2 g2 = (f32x2){ag[2 * h], ag[2 * h + 1]} * (f32x2){sg[2 * h], sg[2 * h + 1]} + (f32x2){bg[2 * h], bg[2 * h + 1]};
                        const f32x2 u2 = (f32x2){au[2 * h], au[2 * h + 1]} * (f32x2){su[2 * h], su[2 * h + 1]} + (f32x2){bu[2 * h], bu[2 * h + 1]};
                        f32x2 gate, uu; gate.x = fminf(g2.x, 7.f); gate.y = fminf(g2.y, 7.f); uu.x = __builtin_amdgcn_fmed3f(u2.x, -7.f, 7.f); uu.y = __builtin_amdgcn_fmed3f(u2.y, -7.f, 7.f);
                        const f32x2 t = gate * (-1.702f * LOG2E); f32x2 d; d.x = __builtin_amdgcn_exp2f(t.x); d.y = __builtin_amdgcn_exp2f(t.y); d = d + 1.f;
                        f32x2 r; r.x = __builtin_amdgcn_rcpf(d.x); r.y = __builtin_amdgcn_rcpf(d.y);
                        const f32x2 a = (uu * gate + gate) * (r * 8.f); o[4 * n + 2 * h] = a.x; o[4 * n + 2 * h + 1] = a.y; } }
                int w0 = __builtin_amdgcn_cvt_pk_fp8_f32(o[0], o[1], 0, false); w0 = __builtin_amdgcn_cvt_pk_fp8_f32(o[2], o[3], w0, true);
                int w1 = __builtin_amdgcn_cvt_pk_fp8_f32(o[4], o[5], 0, false); w1 = __builtin_amdgcn_cvt_pk_fp8_f32(o[6], o[7], w1, true);
                f32x2 st; st.x = __int_as_float(w0); st.y = __int_as_float(w1);
                *(f32x2*)(ACT + (size_t)row * DM + j0) = st;
            }
    }
};
#ifndef ST_Y
#define ST_Y(p, v) (*(u32x4*)(p) = (v))
#endif
struct EpiDown {
    static constexpr bool PERM = true, PREF = false;
    unsigned char* Y; const float* par;
    __device__ __forceinline__ void operator()(const f32x4 (&acc)[2][2][4][2], const Unit& u, int wr, int wc, int fr, int fq) const {
        const int col0 = u.pn * BM + wc * 32 + 8 * fq; const float* pp = par + ((size_t)u.e * (DM / 4) + (col0 >> 2)) * 8;
#pragma unroll
        for (int bj = 0; bj < 2; ++bj) { const f32x4 s0 = *(const f32x4*)(pp + bj * (HALF * 2)), b0 = *(const f32x4*)(pp + bj * (HALF * 2) + 4), s1 = *(const f32x4*)(pp + bj * (HALF * 2) + 8), b1 = *(const f32x4*)(pp + bj * (HALF * 2) + 12);
#pragma unroll
            for (int ai = 0; ai < 2; ++ai)
#pragma unroll
                for (int mp = 0; mp < 2; ++mp) {
                    int w[2][2];
#pragma unroll
                    for (int h = 0; h < 2; ++h) { const int m = 2 * mp + h;
                        const f32x4 v0 = acc[ai][bj][m][0] * s0 + b0, v1 = acc[ai][bj][m][1] * s1 + b1;
                        int w0 = __builtin_amdgcn_cvt_pk_fp8_f32(v0[0], v0[1], 0, false); w[h][0] = __builtin_amdgcn_cvt_pk_fp8_f32(v0[2], v0[3], w0, true);
                        int w1 = __builtin_amdgcn_cvt_pk_fp8_f32(v1[0], v1[1], 0, false); w[h][1] = __builtin_amdgcn_cvt_pk_fp8_f32(v1[2], v1[3], w1, true); }
                    const auto rx = __builtin_amdgcn_permlane16_swap((unsigned)w[0][0], (unsigned)w[1][0], false, false), ry = __builtin_amdgcn_permlane16_swap((unsigned)w[0][1], (unsigned)w[1][1], false, false);
                    const int row = u.pm * BM + ai * HALF + wr * 64 + (2 * mp + (fq & 1)) * 16 + fr;
                    u32x4 o; o.x = rx[0]; o.y = ry[0]; o.z = rx[1]; o.w = ry[1];
                    ST_Y(Y + (size_t)row * DM + (col0 - 8 * (fq & 1)) + bj * HALF, o);
                    asm volatile("" ::: "memory"); }
            asm volatile("" ::: "memory"); }
    }
};

template <class Epi, class Prob>
__device__ __forceinline__ void gemm_phase(LAS unsigned char* lds, const Prob& S, const Epi& E) {
    const int tid = hid_tid(), wid = __builtin_amdgcn_readfirstlane(tid >> 6), lane = tid & 63, wr = wid >> 2, wc = wid & 3, fr = lane & 15, fq = lane >> 4;
    constexpr int KB = Prob::KB, nt = KB / (BK * 2);
    constexpr bool I8 = (Prob::DT == 1), F8 = (Prob::DT == 2);
    constexpr bool GA = Prob::GATHER_A;
    int Rr[2], Cc[2]; unsigned voffB[2], voffA[2];
#pragma unroll
    for (int i = 0; i < 2; ++i) { int R, C; stage_rc(tid * 16 + i * 8192, R, C); Rr[i] = R; Cc[i] = C; voffA[i] = (unsigned)(R * KB + 2 * C); const int Rb = Epi::PERM ? ((R & ~31) + perm32(R & 31)) : R; voffB[i] = (unsigned)(Rb * KB + 2 * C); }
    const size_t kstep = (size_t)(BK * 2);
    const size_t hstep = (size_t)HALF * KB;
    const unsigned ldsb = (unsigned)(size_t)lds;
    const unsigned ldsw = (unsigned)wid * 1024u;
    const unsigned ldsq = (unsigned)__builtin_amdgcn_readfirstlane((int)(ldsb + ldsw));
    const int aoff = lds_byte(wr * 64 + fr, fq * 8), boff = lds_byte(wc * 32 + fr, fq * 8);
#define PG8_SA(b, h) (((b) * 2 + (h)) * HTB)
#define PG8_SB(b, h) ((4 + (b) * 2 + (h)) * HTB)
#define PG8_STAGE(bufoff, gbase, voff) do { glds16i<(bufoff)>((const char*)(gbase), (voff)[0], ldsq); glds16i<(bufoff) + 8192>((const char*)(gbase), (voff)[1], ldsq); } while (0)
#define PG8_GVO(V, h, i) ({ unsigned pk_ = (V)[h][0]; asm volatile("" : "+v"(pk_)); (((pk_ >> (16 * (i))) & 0xffffu) << 10) | (voffB[i] & 1023u); })
#define PG8_STAGE_A(bufoff, gbase, h, V) do { if constexpr (GA) { static_assert(!GA || KB == 1024, "packed gather offsets"); glds16i<(bufoff)>((const char*)(gbase), PG8_GVO(V, h, 0), ldsq); glds16i<(bufoff) + 8192>((const char*)(gbase), PG8_GVO(V, h, 1), ldsq); } else { PG8_STAGE(bufoff, (gbase) + (h) * hstep, voffA); } } while (0)
#define PG8_LDA(dst, b, h) do { _Pragma("unroll") for (int m = 0; m < 4; ++m) { if constexpr (F8) dst##8[m] = __builtin_shufflevector(*(const LAS i32x4*)(lds + PG8_SA(b, h) + aoff + m * 2048), *(const LAS i32x4*)(lds + PG8_SA(b, h) + aoff + m * 2048 + 1024), 0, 1, 2, 3, 4, 5, 6, 7); \
        else { _Pragma("unroll") for (int k = 0; k < 2; ++k) dst[m][k] = *(const LAS bf16x8*)(lds + PG8_SA(b, h) + aoff + m * 2048 + k * 1024); } } } while (0)
#define PG8_LDB(dst, b, h) do { _Pragma("unroll") for (int n = 0; n < 2; ++n) { if constexpr (F8) dst##8[n] = __builtin_shufflevector(*(const LAS i32x4*)(lds + PG8_SB(b, h) + boff + n * 2048), *(const LAS i32x4*)(lds + PG8_SB(b, h) + boff + n * 2048 + 1024), 0, 1, 2, 3, 4, 5, 6, 7); \
        else { _Pragma("unroll") for (int k = 0; k < 2; ++k) dst[n][k] = *(const LAS bf16x8*)(lds + PG8_SB(b, h) + boff + n * 2048 + k * 1024); } } } while (0)
#define PG8_MMA(ai, bj, At, Bt) do { __builtin_amdgcn_s_setprio(1); _Pragma("unroll") for (int m = 0; m < 4; ++m) _Pragma("unroll") for (int n = 0; n < 2; ++n) _Pragma("unroll") for (int k = 0; k < 2; ++k) \
        { if constexpr (F8) { if (k == 0) acc[ai][bj][m][n] = __builtin_amdgcn_mfma_scale_f32_16x16x128_f8f6f4(Bt##8[n], At##8[m], acc[ai][bj][m][n], 0, 0, 0, 0, 0, 0); } \
          else if constexpr (I8) acc[ai][bj][m][n] = __builtin_bit_cast(f32x4, __builtin_amdgcn_mfma_i32_16x16x64_i8(__builtin_bit_cast(i32x4, Bt[n][k]), __builtin_bit_cast(i32x4, At[m][k]), __builtin_bit_cast(i32x4, acc[ai][bj][m][n]), 0, 0, 0)); \
          else acc[ai][bj][m][n] = __builtin_amdgcn_mfma_f32_16x16x32_bf16(Bt[n][k], At[m][k], acc[ai][bj][m][n], 0, 0, 0); } __builtin_amdgcn_s_setprio(0); } while (0)
#define PG8_WAIT_V(n) asm volatile("s_waitcnt vmcnt(" #n ")" ::: "memory")
#define PG8_WAIT_L(n) asm volatile("s_waitcnt lgkmcnt(" #n ")" ::: "memory")
#define PG8_BAR __builtin_amdgcn_s_barrier()
#define PG8_SCHED __builtin_amdgcn_sched_barrier(0)
    Unit cur, nxt; int ui = 0;
    if (!S.next(0, cur)) return;
    f32x4 acc[2][2][4][2];
#pragma unroll
    for (int a = 0; a < 2; ++a)
#pragma unroll
        for (int b = 0; b < 2; ++b)
#pragma unroll
            for (int m = 0; m < 4; ++m)
#pragma unroll
                for (int n = 0; n < 2; ++n) acc[a][b][m][n] = (f32x4){0.f, 0.f, 0.f, 0.f};
    bf16x8 At[4][2], B0[2][2], B1[2][2];
    i32x8 At8[4], B08[2], B18[2];
    unsigned cV[2][2], nV[2][2];
    if constexpr (GA) S.a_voff(cur, cV, Rr, Cc);
    const char* cA = S.a_base(cur); const char* cB = S.b_base(cur);
    PG8_STAGE(PG8_SB(0, 0), cB, voffB); PG8_STAGE(PG8_SB(0, 1), cB + hstep, voffB); PG8_STAGE_A(PG8_SA(0, 0), cA, 0, cV); PG8_STAGE_A(PG8_SA(0, 1), cA, 1, cV);
    if (wr == 1) PG8_BAR;
    PG8_WAIT_V(2); PG8_BAR;
    PG8_STAGE(PG8_SB(1, 0), cB + kstep, voffB); PG8_STAGE_A(PG8_SA(1, 0), cA + kstep, 0, cV); PG8_STAGE(PG8_SB(1, 1), cB + hstep + kstep, voffB);
    PG8_WAIT_V(6); PG8_BAR;
    for (;;) {
        if constexpr (Epi::PREF) E.prefetch(cur, lds, wid, lane, ui & 1);
        const bool has_next = S.next(ui + 1, nxt);
        const char* nA = has_next ? S.a_base(nxt) : cA; const char* nB = has_next ? S.b_base(nxt) : cB;
        if constexpr (GA) { if (has_next) S.a_voff(nxt, nV, Rr, Cc);
        else {
#pragma unroll
            for (int h = 0; h < 2; ++h)
#pragma unroll
                for (int i = 0; i < 2; ++i) nV[h][i] = cV[h][i];
        } }
#define PG8_KBODY(A1, A2, B2, A3, B3, V2) do { \
              \
            PG8_LDB(B0, 0, 0); PG8_LDB(B1, 0, 1); PG8_SCHED; PG8_LDA(At, 0, 0); PG8_STAGE_A(PG8_SA(1, 1), A1, 1, cV); \
            PG8_WAIT_V(8); PG8_WAIT_L(0); PG8_BAR; PG8_MMA(0, 0, At, B0); PG8_MMA(0, 1, At, B1); PG8_BAR; PG8_SCHED; \
              \
            PG8_LDA(At, 0, 1); PG8_STAGE(PG8_SB(0, 0), B2, voffB); PG8_STAGE(PG8_SB(0, 1), (B2) + hstep, voffB); PG8_STAGE_A(PG8_SA(0, 0), A2, 0, V2); \
            PG8_WAIT_V(8); PG8_WAIT_L(0); PG8_BAR; PG8_MMA(1, 0, At, B0); PG8_MMA(1, 1, At, B1); PG8_BAR; PG8_SCHED; \
              \
            PG8_LDB(B0, 1, 0); PG8_LDB(B1, 1, 1); PG8_SCHED; PG8_LDA(At, 1, 0); PG8_STAGE_A(PG8_SA(0, 1), A2, 1, V2); \
            PG8_WAIT_V(8); PG8_WAIT_L(0); PG8_BAR; PG8_MMA(0, 0, At, B0); PG8_MMA(0, 1, At, B1); PG8_BAR; PG8_SCHED; \
              \
            PG8_LDA(At, 1, 1); PG8_STAGE(PG8_SB(1, 0), B3, voffB); PG8_STAGE(PG8_SB(1, 1), (B3) + hstep, voffB); PG8_STAGE_A(PG8_SA(1, 0), A3, 0, V2); \
            PG8_WAIT_V(8); PG8_WAIT_L(0); PG8_BAR; PG8_MMA(1, 0, At, B0); PG8_MMA(1, 1, At, B1); PG8_BAR; PG8_SCHED; } while (0)
        if constexpr (GA) {
            for (int t = 0; t < nt - 2; t += 2) {
                const char* a1 = cA + (size_t)(t + 1) * kstep; const char* a2 = a1 + kstep; const char* b2 = cB + (size_t)(t + 2) * kstep;
                PG8_KBODY(a1, a2, b2, a2 + kstep, b2 + kstep, cV);
            }
            { const char* a1 = cA + (size_t)(nt - 1) * kstep; PG8_KBODY(a1, nA, nB, nA + kstep, nB + kstep, nV); }
        } else {
            for (int t = 0; t < nt; t += 2) {
                const bool last = (t == nt - 2);
                const char* a1 = cA + (size_t)(t + 1) * kstep;
                const char* a2 = last ? nA : cA + (size_t)(t + 2) * kstep; const char* b2 = last ? nB : cB + (size_t)(t + 2) * kstep;
                PG8_KBODY(a1, a2, b2, a2 + kstep, b2 + kstep, cV);
            }
        }
#undef PG8_KBODY
        if (wr == 0) PG8_BAR;
        PG8_SCHED;
        if constexpr (I8) {
#pragma unroll
            for (int a = 0; a < 2; ++a)
#pragma unroll
                for (int b = 0; b < 2; ++b)
#pragma unroll
                    for (int m = 0; m < 4; ++m)
#pragma unroll
                        for (int n = 0; n < 2; ++n) acc[a][b][m][n] = __builtin_convertvector(__builtin_bit_cast(i32x4, acc[a][b][m][n]), f32x4); }
        { int tz = threadIdx.x; asm volatile("" : "+v"(tz)); const int l2 = tz & 63; if constexpr (Epi::PREF) E.run(acc, cur, wr, wc, l2 & 15, l2 >> 4, lds, ui & 1); else E(acc, cur, wr, wc, l2 & 15, l2 >> 4); }
        if (!has_next) break;
#pragma unroll
        for (int a = 0; a < 2; ++a)
#pragma unroll
            for (int b = 0; b < 2; ++b)
#pragma unroll
                for (int m = 0; m < 4; ++m)
#pragma unroll
                    for (int n = 0; n < 2; ++n) acc[a][b][m][n] = (f32x4){0.f, 0.f, 0.f, 0.f};
        cur = nxt; cA = nA; cB = nB; ++ui;
        if constexpr (GA) {
#pragma unroll
            for (int h = 0; h < 2; ++h)
#pragma unroll
                for (int i = 0; i < 2; ++i) cV[h][i] = nV[h][i]; }
        if (wr == 1) PG8_BAR;
    }
    PG8_WAIT_V(0);
    PG8_BAR;
#undef PG8_SA
#undef PG8_SB
#undef PG8_STAGE
#undef PG8_STAGE_A
#undef PG8_LDA
#undef PG8_LDB
#undef PG8_MMA
#undef PG8_WAIT_V
#undef PG8_WAIT_L
#undef PG8_BAR
#undef PG8_SCHED
}
}


__device__ __forceinline__ void moe_tables(const int* hist, LAS unsigned char* lds, const int gsel = -1) {
    LAS int* poff = (LAS int*)(lds + L_POFF); LAS int* tot = (LAS int*)(lds + L_TOT); LAS int* tile_e = (LAS int*)(lds + L_TILEE); LAS int* part = (LAS int*)(lds + L_PART);
    const int tid = hid_tid();
    { const int e = tid & 31, p = tid >> 5; int s = 0;
        int pre = 0;
#pragma unroll
        for (int q = 0; q < 16; ++q) { const int h = hist[(p * 16 + q) * NE + e]; s += h; pre += (q < (gsel & 15)) ? h : 0; }
        part[p * NE + e] = s; if (gsel >= 0 && p == (gsel >> 4)) ((LAS int*)(lds + L_LG))[e] = pre; }
    __syncthreads();
    if (tid < NE) { int s = 0;
#pragma unroll
        for (int p = 0; p < 16; ++p) s += part[p * NE + tid];
        tot[tid] = s; }
    __syncthreads();
    if (tid == 0) { int o = 0; for (int e = 0; e < NE; ++e) { poff[e] = o; o += ((tot[e] + 255) >> 8) << 8; } poff[NE] = o; }
    __syncthreads();
    if (tid < 320) { const int s0 = tid * 256; int e = 0; for (int q = 0; q < NE; ++q) if (poff[q] <= s0) e = q; tile_e[tid] = e; }
    __syncthreads();
}

struct WItem { const float* W; int ldw; bf16_t* WT; int dst, k0, n0; };
__device__ __forceinline__ void transpose_emit(const f32x4 (&v)[8], const WItem& it, LAS float*, int lane) {
    bf16_t* op = it.WT + (size_t)(it.dst + 4 * (lane & 7)) * DM + it.k0 + 8 * (lane >> 3);
#pragma unroll
    for (int q = 0; q < 4; ++q) { u32x4 o; o.x = pg8::cvt_pk_bf16(v[0][q], v[1][q]); o.y = pg8::cvt_pk_bf16(v[2][q], v[3][q]); o.z = pg8::cvt_pk_bf16(v[4][q], v[5][q]); o.w = pg8::cvt_pk_bf16(v[6][q], v[7][q]);
        *(u32x4*)(op + (size_t)q * DM) = o; }
}
__device__ __forceinline__ void transpose_load(f32x4 (&v)[8], const WItem& it, int lane) {
    const unsigned voff = (unsigned)((8 * (lane >> 3)) * it.ldw + 4 * (lane & 7)) * 4u; const char* wb = (const char*)(it.W + (size_t)it.k0 * it.ldw + it.n0);
#pragma unroll
    for (int i = 0; i < 8; ++i) v[i] = *(const f32x4*)(wb + (size_t)i * it.ldw * 4 + voff);
}
__device__ __forceinline__ void transpose_pair(const WItem& a, const WItem& b, LAS float* scr, int lane) {
    f32x4 va[8], vb[8]; transpose_load(va, a, lane); transpose_load(vb, b, lane);
    transpose_emit(va, a, scr, lane); transpose_emit(vb, b, scr, lane);
}
constexpr int I_IN = 16 * (INW / 32), I_OUT = 16 * (DM / 32), I_GU = 16 * (2 * DM / 32), I_D = 16 * (DM / 32);
constexpr int N_SMALL_ITEMS = I_IN + I_OUT;
__device__ __forceinline__ WItem witem_small(CtxK& C, int r) {
    if (r < I_IN) { const int kb = r / (INW / 32), nb = r % (INW / 32); return WItem{C.w_in, INW, WSP(bf16_t, WS_WIN_T), 32 * nb, 64 * kb, 32 * nb}; }
    r -= I_IN; const int kb = r / (DM / 32), nb = r % (DM / 32); return WItem{C.w_out, DM, WSP(bf16_t, WS_WOUT_T), 32 * nb, 64 * kb, 32 * nb};
}
__device__ __forceinline__ WItem witem_moe(CtxK& C, int r) {
    if (r < NE * I_GU) { const int e = r / I_GU, q = r % I_GU, kb = q / (2 * DM / 32), nb = q % (2 * DM / 32), n0 = 32 * nb;
        const int dst = (n0 < DM) ? (256 * (n0 >> 7) + (n0 & 127)) : (256 * ((n0 - DM) >> 7) + 128 + ((n0 - DM) & 127));
        return WItem{C.w_gate_up + (size_t)e * DM * 2 * DM, 2 * DM, WSP(bf16_t, WS_WGU_T) + (size_t)e * 2 * DM * DM, dst, 64 * kb, n0}; }
    r -= NE * I_GU; const int e = r / I_D, q = r % I_D, kb = q / (DM / 32), nb = q % (DM / 32);
    return WItem{C.w_down + (size_t)e * DM * DM, DM, WSP(bf16_t, WS_WD_T) + (size_t)e * DM * DM, 32 * nb, 64 * kb, 32 * nb};
}
__device__ __forceinline__ unsigned q8(float x, float inv) { int q = __float2int_rn(x * inv); q = q < -127 ? -127 : (q > 127 ? 127 : q); return (unsigned)q & 255u; }
__device__ __forceinline__ unsigned pack_q8(float a, float b, float c, float d, float inv) { return q8(a, inv) | (q8(b, inv) << 8) | (q8(c, inv) << 16) | (q8(d, inv) << 24); }
__device__ __forceinline__ void phase_weights(CtxK& C, LAS unsigned char* lds, int gw, int ngw, int wave, int lane) {
    LAS float* scr = (LAS float*)(lds + RING_OFF + wave * 16384);
    unsigned* cmax0 = WSP(unsigned, WS_CTL) + CW_CMAX_IN;
    for (int it = gw; it < I_IN + I_OUT; it += ngw) { const WItem w = witem_small(C, it); f32x4 v[8]; transpose_load(v, w, lane); unsigned* cmax = cmax0 + (it < I_IN ? 0 : INW);
        f32x4 m = __builtin_elementwise_abs(v[0]);
#pragma unroll
        for (int i = 1; i < 8; ++i) m = __builtin_elementwise_max(m, __builtin_elementwise_abs(v[i]));
#pragma unroll
        for (int q = 0; q < 4; ++q) { float a = m[q]; a = fmaxf(a, row_ror<8>(a)); m[q] = rows_max(a); }
        if (lane < 8) {
#pragma unroll
            for (int q = 0; q < 4; ++q) atomicMax(cmax + w.n0 + 4 * lane + q, __float_as_uint(m[q])); }
    }
}
__device__ __forceinline__ void phase_quant_win(CtxK& C, int gw, int ngw, int lane) {
    const unsigned* cmax0 = WSP(unsigned, WS_CTL) + CW_CMAX_IN;
    for (int it = gw; it < I_IN + I_OUT; it += ngw) { const WItem w = witem_small(C, it); f32x4 v[8]; transpose_load(v, w, lane);
        const bool isin = it < I_IN; const unsigned* cmax = cmax0 + (isin ? 0 : INW); unsigned char* W8 = isin ? WSP(unsigned char, WS_WIN8) : WSP(unsigned char, WS_WOUT8); float* sb = isin ? WSP(float, WS_SBIN) : WSP(float, WS_SBOUT);
        const int r = lane >> 3, c4 = lane & 7;
#pragma unroll
        for (int q = 0; q < 4; ++q) { const int n = w.n0 + 4 * c4 + q; const float cm = __uint_as_float(__hip_atomic_load(cmax + n, __ATOMIC_RELAXED, __HIP_MEMORY_SCOPE_AGENT)); const float inv = cm > 0.f ? 127.f / cm : 0.f;
            f32x2 o; o.x = __uint_as_float(pack_q8(v[0][q], v[1][q], v[2][q], v[3][q], inv)); o.y = __uint_as_float(pack_q8(v[4][q], v[5][q], v[6][q], v[7][q], inv));
            *(f32x2*)(W8 + (size_t)n * DM + w.k0 + 8 * r) = o;
            if (w.k0 == 0 && r == 0) sb[n] = cm * (1.f / 127.f); }
    }
}
__device__ __forceinline__ f32x4 colmax_regs(const f32x4 (&v)[8]) {
    f32x4 m = __builtin_elementwise_abs(v[0]);
#pragma unroll
    for (int i = 1; i < 8; ++i) m = __builtin_elementwise_max(m, __builtin_elementwise_abs(v[i]));
#pragma unroll
    for (int q = 0; q < 4; ++q) { float a = m[q]; a = fmaxf(a, row_ror<8>(a)); m[q] = rows_max(a); }
    return m;
}
__device__ __forceinline__ void quant_regs16(const f32x4 (&lo)[8], const f32x4 (&hi)[8], f32x4 cm, unsigned char* dst  ) {
#pragma unroll
    for (int q = 0; q < 4; ++q) { const float inv = cm[q] > 0.f ? 127.f / cm[q] : 0.f;
        u32x4 o; o.x = pack_q8(lo[0][q], lo[1][q], lo[2][q], lo[3][q], inv); o.y = pack_q8(lo[4][q], lo[5][q], lo[6][q], lo[7][q], inv);
        o.z = pack_q8(hi[0][q], hi[1][q], hi[2][q], hi[3][q], inv); o.w = pack_q8(hi[4][q], hi[5][q], hi[6][q], hi[7][q], inv);
        *(u32x4*)(dst + (size_t)q * DM) = o; }
}
__device__ __forceinline__ unsigned pack_f8(float a, float b, float c, float d, float inv) { int w = __builtin_amdgcn_cvt_pk_fp8_f32(a * inv, b * inv, 0, false); w = __builtin_amdgcn_cvt_pk_fp8_f32(c * inv, d * inv, w, true); return (unsigned)w; }
__device__ __forceinline__ void quant_regs16_f8(const f32x4 (&lo)[8], const f32x4 (&hi)[8], f32x4 cm, unsigned char* dst) {
#pragma unroll
    for (int q = 0; q < 4; ++q) { const float inv = cm[q] > 0.f ? 448.f / cm[q] : 0.f;
        u32x4 o; o.x = pack_f8(lo[0][q], lo[1][q], lo[2][q], lo[3][q], inv); o.y = pack_f8(lo[4][q], lo[5][q], lo[6][q], lo[7][q], inv);
        o.z = pack_f8(hi[0][q], hi[1][q], hi[2][q], hi[3][q], inv); o.w = pack_f8(hi[4][q], hi[5][q], hi[6][q], hi[7][q], inv);
        *(u32x4*)(dst + (size_t)q * DM) = o; }
}
constexpr int N_SCHUNKS = NE * 64, N_ZCHUNKS = NE * 32;
template <int KIND> __device__ __forceinline__ void chunk_dma(CtxK& C, LAS unsigned char* lds, int chunk, int wave, int lane) {
    constexpr int PITCH = KIND ? DM : 2 * DM, HSPE = PITCH / 32;
    const int e = chunk / HSPE, n0 = 32 * (chunk % HSPE);
    const char* wb = (const char*)((KIND ? C.w_down : C.w_gate_up) + (size_t)e * DM * PITCH + (size_t)(128 * wave) * PITCH + n0);
    const unsigned voff = (unsigned)((lane >> 3) * PITCH + 4 * (lane & 7)) * 4u;
    const unsigned ldsq = (unsigned)__builtin_amdgcn_readfirstlane((int)((unsigned)(size_t)(lds + RING_OFF) + (unsigned)wave * 16384u));
#define CH_DMA(b) pg8::glds16i<(b) * 1024>(wb + (size_t)(b) * 8 * PITCH * 4, voff, ldsq)
    CH_DMA(0); CH_DMA(1); CH_DMA(2); CH_DMA(3); CH_DMA(4); CH_DMA(5); CH_DMA(6); CH_DMA(7); CH_DMA(8); CH_DMA(9); CH_DMA(10); CH_DMA(11); CH_DMA(12); CH_DMA(13); CH_DMA(14); CH_DMA(15);
#undef CH_DMA
}
__device__ __forceinline__ void chunk_read(f32x4 (&lo)[8], f32x4 (&hi)[8], LAS unsigned char* lds, int wave, int lane) {
    const LAS unsigned char* pb = lds + RING_OFF + wave * 16384 + (lane >> 3) * 2048 + (lane & 7) * 16;
#pragma unroll
    for (int i = 0; i < 8; ++i) { lo[i] = *(const LAS f32x4*)(pb + i * 128); hi[i] = *(const LAS f32x4*)(pb + 1024 + i * 128); }
}
template <int KIND> __device__ __forceinline__ void chunk_emit(CtxK& C, const f32x4 (&lo)[8], const f32x4 (&hi)[8], f32x4 cm, int chunk, int wave, int lane) {
    constexpr int PITCH = KIND ? DM : 2 * DM, HSPE = PITCH / 32;
    const int e = chunk / HSPE, n0 = 32 * (chunk % HSPE), r = lane >> 3, c4 = lane & 7, kA = 128 * wave;
    if constexpr (KIND == 0) {
        const int dst0 = (n0 < DM) ? (256 * (n0 >> 7) + (n0 & 127)) : (256 * ((n0 - DM) >> 7) + 128 + ((n0 - DM) & 127));
        unsigned char* W8e = WSP(unsigned char, WS_WGU8) + (size_t)e * 2 * DM * DM;
        quant_regs16_f8(lo, hi, cm, W8e + (size_t)(dst0 + 4 * c4) * DM + kA + 16 * r);
        if (wave == 0 && lane < 8) { float* sbe = WSP(float, WS_SBGU) + e * 2 * DM + n0; *(f32x4*)(sbe + 4 * lane) = cm * (1.f / 448.f); }
    } else {
        unsigned char* W8e = WSP(unsigned char, WS_WD8) + (size_t)e * DM * DM;
        quant_regs16_f8(lo, hi, cm, W8e + (size_t)(n0 + 4 * c4) * DM + kA + 16 * r);
        if (wave == 0 && lane < 8) { float* sbe = WSP(float, WS_SBD) + ((size_t)e * (DM / 4) + (n0 >> 2) + lane) * 8;
            *(f32x4*)sbe = cm * (1.f / (448.f * 8.f)); *(f32x4*)(sbe + 4) = *(const f32x4*)(C.b_down + (size_t)e * DM + n0 + 4 * lane); }
    }
}

__device__ __forceinline__ void phase_proj(CtxK& C, LAS unsigned char* lds) {
    pg8::ProbDense<1024> S; S.init(WSP(char, WS_H8), WSP(char, WS_WIN8), NTOK, INW, (int)gridDim.x, (int)blockIdx.x);
    pg8::EpiProj E{WSP(bf16_t, WS_PQ), WSP(float, WS_ROPE), WSP(float, WS_SA), WSP(float, WS_SBIN)};
    pg8::gemm_phase<pg8::EpiProj, pg8::ProbDense<1024>>(lds + RING_OFF, S, E);
}
__device__ __forceinline__ void phase_out(CtxK& C, LAS unsigned char* lds) {
    pg8::ProbDense<1024> S; S.init(WSP(char, WS_MIX8), WSP(char, WS_WOUT8), NTOK, DM, (int)gridDim.x, (int)blockIdx.x);
    pg8::EpiOut E{C.x, WSP(float, WS_MOD), WSP(bf16_t, WS_X1), WSP(float, WS_SAM), WSP(float, WS_SBOUT)};
    pg8::gemm_phase<pg8::EpiOut, pg8::ProbDense<1024>>(lds + RING_OFF, S, E);
}
__device__ __forceinline__ void phase_gate_up(CtxK& C, LAS unsigned char* lds, const int t0, const int ntile, const int xrot) {
    pg8::ProbMoE<true, 1024, 2> S{(const char*)WSP(char, WS_H8F), (const char*)WSP(char, WS_WGU8), WSP(int, WS_TOKSLOT), (const LAS int*)(lds + L_TILEE), ntile, 8, (int)gridDim.x, (int)blockIdx.x, t0, xrot};
    pg8::EpiGateUp E{WSP(unsigned char, WS_ACT), C.b_gate_up, WSP(float, WS_SAS), WSP(float, WS_SBGU)};
    pg8::gemm_phase<pg8::EpiGateUp, pg8::ProbMoE<true, 1024, 2>>(lds + RING_OFF, S, E);
}
__device__ __forceinline__ void phase_down(CtxK& C, LAS unsigned char* lds, const int t0, const int ntile, const int xrot) {
    pg8::ProbMoE<false, 1024, 2> S{(const char*)WSP(char, WS_ACT), (const char*)WSP(char, WS_WD8), WSP(int, WS_TOKSLOT), (const LAS int*)(lds + L_TILEE), ntile, 4, (int)gridDim.x, (int)blockIdx.x, t0, xrot};
    pg8::EpiDown E{WSP(unsigned char, WS_Y), WSP(float, WS_SBD)};
    pg8::gemm_phase<pg8::EpiDown, pg8::ProbMoE<false, 1024, 2>>(lds + RING_OFF, S, E);
}


namespace attn_body {
using bf16=__hip_bfloat16;
using bf16x8=__attribute__((ext_vector_type(8)))short;
using s16x4=__attribute__((ext_vector_type(4)))short;
using f32x16=__attribute__((ext_vector_type(16)))float;
using u32x4=__attribute__((ext_vector_type(4)))unsigned;
constexpr int D=64,PIN=3072,POUT=1024;
constexpr int NW=8,QBLK=32,QB=QBLK*NW,KVBLK=64,NQB=SEQ/QB;
__device__ __forceinline__ int crow(int r,int hi){return (r&3)+8*(r>>2)+4*hi;}
#define SBAR() __builtin_amdgcn_sched_barrier(0)
__device__ __forceinline__ void negall(f32x16&p0,f32x16&p1){
  const float NEG=-INFINITY;
  #pragma unroll
  for(int r=0;r<16;++r){p0[r]=NEG;p1[r]=NEG;}
}
typedef __attribute__((address_space(3))) const float* lds_cfptr;
__device__ __forceinline__ void bias_add(f32x16&p0,f32x16&p1,int dc,int qi,int hi,lds_cfptr tab){
  const int base=dc*64+qi-4*hi+128;
  #pragma unroll
  for(int g=0;g<4;++g){
    #pragma unroll
    for(int j=0;j<4;++j){const int r=4*g+j; const int k=(r&3)+8*(r>>2); int i0=base-k,i1=base-k-32; i0=i0>256?256:i0; i1=i1>256?256:i1; p0[r]+=tab[i0]; p1[r]+=tab[i1];}
    asm volatile("":"+v"(p0),"+v"(p1)::"memory"); }
}

constexpr int NSLOT=3, SLOTB=8192;
constexpr int LDS_K=0, LDS_V=NSLOT*SLOTB;
constexpr int LDS_BYTES=LDS_V+2*NSLOT*SLOTB+NW*64*4+NW*4096+1280;
constexpr float C2=0.125f*1.4426950408889634f;
__device__ __forceinline__ void glds16(const void*gsrc,unsigned lds_dst){unsigned keep;
  asm volatile("s_mov_b32 %0, m0\n\ts_mov_b32 m0, %2\n\ts_nop 0\n\tglobal_load_lds_dwordx4 %1, off\n\ts_mov_b32 m0, %0":"=&s"(keep):"v"(gsrc),"s"(lds_dst):"memory");}
__device__ __forceinline__ float max3f(float a,float b,float c){float r;asm("v_max3_f32 %0, %1, %2, %3":"=v"(r):"v"(a),"v"(b),"v"(c));return r;}
__device__ __forceinline__ float max2f(float a,float b){float r;asm("v_max_f32_e32 %0, %1, %2":"=v"(r):"v"(a),"v"(b));return r;}
__device__ __forceinline__ float fadd_s(float a,float b){float r;asm("v_add_f32_e32 %0, %1, %2":"=v"(r):"v"(a),"v"(b));return r;}
__device__ __forceinline__ float fsub_s(float a,float b){float r;asm("v_sub_f32_e32 %0, %1, %2":"=v"(r):"v"(a),"v"(b));return r;}
typedef float f32x2_t __attribute__((ext_vector_type(2))); typedef __bf16 bf16x2_t __attribute__((ext_vector_type(2)));
__device__ __forceinline__ unsigned cvtpk_s(float lo,float hi){f32x2_t v={lo,hi};bf16x2_t b=__builtin_convertvector(v,bf16x2_t);return __builtin_bit_cast(unsigned,b);}
#define WAIT_BAR(N) asm volatile("s_waitcnt vmcnt(" #N ") lgkmcnt(0)\n\ts_barrier":::"memory")

__device__ __forceinline__ void qkt(f32x16&p0,f32x16&p1,const char*Kslot,const bf16x8*qr,const f32x16&negm,int r32,int hi){
  const char*kb=Kslot+hi*1024+r32*16;
  #pragma unroll
  for(int d0=0;d0<4;++d0){
    const bf16x8 b0=*reinterpret_cast<const bf16x8*>(kb+d0*2048);
    const bf16x8 b1=*reinterpret_cast<const bf16x8*>(kb+d0*2048+512);
    if(d0==0){p0=__builtin_amdgcn_mfma_f32_32x32x16_bf16(b0,qr[0],negm,0,0,0);p1=__builtin_amdgcn_mfma_f32_32x32x16_bf16(b1,qr[0],negm,0,0,0);}
    else{p0=__builtin_amdgcn_mfma_f32_32x32x16_bf16(b0,qr[d0],p0,0,0,0);p1=__builtin_amdgcn_mfma_f32_32x32x16_bf16(b1,qr[d0],p1,0,0,0);}}
}
typedef __attribute__((address_space(3))) const char* lds_cptr;
typedef short v4i16_t __attribute__((ext_vector_type(4)));
__device__ __forceinline__ void kload8(bf16x8*kf,lds_cptr kp){
  kf[0]=*(const __attribute__((address_space(3))) bf16x8*)(kp);      kf[1]=*(const __attribute__((address_space(3))) bf16x8*)(kp+512);
  kf[2]=*(const __attribute__((address_space(3))) bf16x8*)(kp+2048); kf[3]=*(const __attribute__((address_space(3))) bf16x8*)(kp+2560);
  kf[4]=*(const __attribute__((address_space(3))) bf16x8*)(kp+4096); kf[5]=*(const __attribute__((address_space(3))) bf16x8*)(kp+4608);
  kf[6]=*(const __attribute__((address_space(3))) bf16x8*)(kp+6144); kf[7]=*(const __attribute__((address_space(3))) bf16x8*)(kp+6656);
}
__device__ __forceinline__ void kload2(bf16x8*kf,lds_cptr kp,int j){ kf[2*j]=*(const __attribute__((address_space(3))) bf16x8*)(kp+j*2048); kf[2*j+1]=*(const __attribute__((address_space(3))) bf16x8*)(kp+j*2048+512); }
__device__ __forceinline__ s16x4 vtr(lds_cptr p){ return __builtin_bit_cast(s16x4,__builtin_amdgcn_ds_read_tr16_b64_v4i16((__attribute__((address_space(3))) v4i16_t*)p)); }
__device__ __forceinline__ float rowmax(const f32x16&p0,const f32x16&p1){
  float a=max3f(p0[0],p0[1],p1[0]),b=max3f(p0[2],p0[3],p1[1]);a=max3f(a,p1[2],p1[3]);
  #pragma unroll
  for(int r=4;r<16;r+=4){a=max3f(a,p0[r],p0[r+1]);b=max3f(b,p0[r+2],p0[r+3]);a=max3f(a,p1[r],p1[r+1]);b=max3f(b,p1[r+2],p1[r+3]);}
  const float m=max2f(a,b);
  auto rr=__builtin_amdgcn_permlane32_swap(__float_as_uint(m),__float_as_uint(m),false,false);
  return max2f(__uint_as_float(rr[0]),__uint_as_float(rr[1]));
}
template<int NDQ> __device__ __forceinline__ void pv(f32x16*o,int vb,bf16x8 pa0,bf16x8 pa1,bf16x8 pa2,bf16x8 pa3){
  #pragma unroll
  for(int d0=0;d0<NDQ;++d0){s16x4 lo[4],hi[4];
    #pragma unroll
    for(int ks=0;ks<4;++ks){
      asm volatile("ds_read_b64_tr_b16 %0,%1 offset:%c2":"=&v"(lo[ks]):"v"(vb),"i"(d0*4096+ks*1024):"memory");
      asm volatile("ds_read_b64_tr_b16 %0,%1 offset:%c2":"=&v"(hi[ks]):"v"(vb),"i"(d0*4096+ks*1024+512):"memory");}
    asm volatile("s_waitcnt lgkmcnt(0)":::"memory");SBAR();
    #define PK(k) (bf16x8){lo[k][0],lo[k][1],lo[k][2],lo[k][3],hi[k][0],hi[k][1],hi[k][2],hi[k][3]}
    o[d0]=__builtin_amdgcn_mfma_f32_32x32x16_bf16(pa0,PK(0),o[d0],0,0,0);
    o[d0]=__builtin_amdgcn_mfma_f32_32x32x16_bf16(pa1,PK(1),o[d0],0,0,0);
    o[d0]=__builtin_amdgcn_mfma_f32_32x32x16_bf16(pa2,PK(2),o[d0],0,0,0);
    o[d0]=__builtin_amdgcn_mfma_f32_32x32x16_bf16(pa3,PK(3),o[d0],0,0,0);
    #undef PK
  }
}

#ifndef ATTN_STORE16
#define ATTN_STORE16(p,v) (::st16_wt((void*)(p),(::u32x4)(v)))
#endif
template<int MODE,int THRL> __device__ __forceinline__ void attn_unit(int b,int qb,const bf16*Qc,const bf16*__restrict__ Kc,const bf16*__restrict__ Vc,bf16*Oc,const float*bias_h,char*shm){
  const int tid=hid_tid(),lane=tid&63,r32=lane&31,hi=lane>>5; const int wid=__builtin_amdgcn_readfirstlane(tid>>6);
  const long rowbase=(long)b*SEQ; const int q0=qb*QB;
  const bf16*Qw=Qc+(rowbase+q0+wid*QBLK)*PIN;
  const bf16*Kh=Kc+rowbase*PIN,*Vh=Vc+rowbase*PIN;
  const unsigned lds0=(unsigned)(uintptr_t)shm;
  constexpr int NDQ=(MODE==1)?4:2, VSL=(MODE==1)?2:1;
  constexpr int LDS_WS=LDS_V+VSL*NSLOT*SLOTB, LDS_OST=LDS_WS+NW*64*4, LDS_TAB=LDS_OST+NW*4096;
  float*wsf=(float*)(shm+LDS_WS)+wid*64;
  const bf16*ksrc=Kh+(long)lane*PIN+wid*8;
  const bf16*vsrc=Vh+(long)(16*(wid&3)+(lane>>2))*PIN+(wid>>2)*32+(lane&3)*8;
  const unsigned kdst=lds0+LDS_K+wid*1024, vdst=lds0+LDS_V+wid*1024;
  const int lo_=(MODE==0)?((4*qb-8)>0?(4*qb-8):0):0; const int NT=(MODE==0)?(4*qb+4-lo_):(q0+QB)/KVBLK; const int rot_=4*qb-lo_;
  #define TIDX(t) ((MODE==0)?(lo_+(((t)+rot_)>=NT?((t)+rot_-NT):((t)+rot_))):(t))
  #define DMA_K(t,slot) glds16(ksrc+(long)TIDX(t)*KVBLK*PIN,(unsigned)__builtin_amdgcn_readfirstlane(kdst+(slot)))
  #define DMA_V(t,slot) do{ glds16(vsrc+(long)TIDX(t)*KVBLK*PIN,(unsigned)__builtin_amdgcn_readfirstlane(vdst+VSL*(slot))); \
      if(MODE==1) glds16(vsrc+(long)TIDX(t)*KVBLK*PIN+64,(unsigned)__builtin_amdgcn_readfirstlane(vdst+VSL*(slot)+8192)); }while(0)
  const int vb0=(int)(lds0+LDS_V)+((lane>>4)&1)*32+(lane&3)*8+(4*hi+((lane&15)>>2))*64;
  const char*Kbase=shm+LDS_K; bf16x8 kf[8];
  const lds_cptr shm3=(lds_cptr)shm; const lds_cptr kp0=shm3+LDS_K+hi*1024+r32*16; const lds_cptr vp0=shm3+LDS_V+((lane>>4)&1)*32+(lane&3)*8+(4*hi+((lane&15)>>2))*64;
  const lds_cfptr tab=(lds_cfptr)(shm3+LDS_TAB);
  if(MODE==0){ int tz=threadIdx.x; asm volatile("":"+v"(tz)); if(tz<257){ ((__attribute__((address_space(3))) float*)(shm3+LDS_TAB))[tz]=(bias_h[tz]-bias_h[256])*1.4426950408889634f; } }
  DMA_K(0,0);DMA_V(0,0);DMA_K(1,SLOTB);
  bf16x8 qr[4];
  #pragma unroll
  for(int d0=0;d0<4;++d0)qr[d0]=*reinterpret_cast<const bf16x8*>(&Qw[(long)r32*PIN+d0*16+hi*8]);
  float mhat=0.f,l_reg=0.f;f32x16 o[NDQ]; _Pragma("unroll") for(int d_=0;d_<NDQ;++d_)o[d_]=f32x16{}; constexpr bool USE_NEGM=false; f32x16 negm=f32x16{};if(USE_NEGM)asm volatile("":"+v"(negm));
  const int cqw=4*qb+(wid>>1), qi=(wid&1)*32+r32;
  #define HOOK(P0,P1,t) do{ if(MODE==1){ const int jb_=(t)-(NT-4); if(jb_>(wid>>1))negall(P0,P1); } else { const int dc_=cqw-TIDX(t); if(dc_<0||dc_>8)negall(P0,P1); else if(dc_<=2)bias_add(P0,P1,dc_,qi,hi,tab); } }while(0)
  #define CMASK(P0,P1,t) HOOK(P0,P1,t)
  bool resc=false;
    \
  #define START(P0,P1) do{ const float rm=rowmax(P0,P1); resc=false; \
    if(__any(rm>(float)THRL)){ const float dl=__builtin_fmaxf(rm,0.f); mhat=fadd_s(mhat,dl); \
      _Pragma("unroll") for(int r=0;r<16;++r){P0[r]=fsub_s(P0[r],dl);P1[r]=fsub_s(P1[r],dl);} \
      if(USE_NEGM){ _Pragma("unroll") for(int r=0;r<16;++r)negm[r]=-mhat; asm volatile("":"+v"(negm)); } } \
    _Pragma("unroll") for(int r=0;r<16;++r)P0[r]=__builtin_amdgcn_exp2f(P0[r]); }while(0)
  #define RESC() do{ if(resc){ asm volatile("s_waitcnt lgkmcnt(0)":::"memory"); \
      _Pragma("unroll") for(int d_=0;d_<NDQ;++d_) _Pragma("unroll") for(int r=0;r<16;++r)o[d_][r]*=wsf[crow(r,hi)]; } }while(0)
  f32x16 pA0,pA1,pB0,pB1;
  int sl_prev=0,sl_cur=0,sl_next=SLOTB;
  #define ROT() do{sl_prev=sl_cur;sl_cur=sl_next;sl_next=(sl_next==(NSLOT-1)*SLOTB)?0:sl_next+SLOTB;}while(0)
  DMA_K(2,2*SLOTB);
  WAIT_BAR(3);
  qkt(pA0,pA1,Kbase,qr,negm,r32,hi);asm volatile("s_nop 15\n\ts_nop 7":"+v"(pA0),"+v"(pA1));CMASK(pA0,pA1,0);
  START(pA0,pA1);
  _Pragma("unroll") for(int r=0;r<16;++r)pA1[r]=__builtin_amdgcn_exp2f(pA1[r]);
  WAIT_BAR(0);
  DMA_K(3,0);DMA_V(1,SLOTB);
  ROT();
  kload8(kf,kp0+sl_cur);
  if(MODE==1){WAIT_BAR(3);}else{WAIT_BAR(2);}
  s16x4 vlo[8],vhi[8]; u32x4 pw0,pw1,pw2,pw3;
  #define PKW(P,B) cvtpk_s(P[B],P[B+1])
  #define PAF(k) __builtin_bit_cast(bf16x8,pw##k)
  #define VFR(i) (bf16x8){vlo[i][0],vlo[i][1],vlo[i][2],vlo[i][3],vhi[i][0],vhi[i][1],vhi[i][2],vhi[i][3]}
  #define PIN(x) asm volatile("":"+v"(x))
  #define MX3(a,b,c) __builtin_fmaxf(__builtin_fmaxf((a),(b)),(c))
  #define GAPA(MF,A0,A1,A2,A3,W0,W1,PW) do{ MF; sacc+=A0; sacc+=A1; sacc+=A2; sacc+=A3; PIN(sacc); W0; W1; PIN(PW); SBAR(); }while(0)
  #define EX(v) __builtin_amdgcn_exp2f(v)
  #define GAPB(MF,X,B) do{ MF; X[B]=EX(X[B]); X[B+1]=EX(X[B+1]); X[B+2]=EX(X[B+2]); X[B+3]=EX(X[B+3]); PIN(X); SBAR(); }while(0)
  #define VRD(i) do{ vlo[i]=vtr(vp_+(((i)>>2)*4096+((i)&3)*1024)); vhi[i]=vtr(vp_+(((i)>>2)*4096+((i)&3)*1024+512)); }while(0)
  #define VRD2(i) do{ vlo[i]=vtr(vp_+((((i)>>2)+2)*4096+((i)&3)*1024)); vhi[i]=vtr(vp_+((((i)>>2)+2)*4096+((i)&3)*1024+512)); }while(0)
  #define GAPB2(MF,X,B) do{ MF; X[B]=EX(X[B]); X[B+1]=EX(X[B+1]); PIN(X); SBAR(); }while(0)
  #define KRD(G,j) do{ if(G){ kload2(kf,kp0+sl_next,j); SBAR(); } }while(0)
  #define STEP(C0,C1,P0,P1,t,GK,GV,GL) do{ SBAR(); \
    const lds_cptr vp_=vp0+VSL*sl_prev; \
    VRD(0); SBAR(); float sacc=(P0[0]+P0[1]); \
    GAPA(C0=__builtin_amdgcn_mfma_f32_32x32x16_bf16(kf[0],qr[0],negm,0,0,0), P0[2],P0[3],P0[4],P0[5],     pw0[0]=PKW(P0,0), pw0[1]=PKW(P0,2), pw0); \
    VRD(4); SBAR(); GAPA(C1=__builtin_amdgcn_mfma_f32_32x32x16_bf16(kf[1],qr[0],negm,0,0,0), P0[6],P0[7],P0[8],P0[9],     pw0[2]=PKW(P0,4), pw0[3]=PKW(P0,6), pw0); \
    VRD(1); SBAR(); GAPA(C0=__builtin_amdgcn_mfma_f32_32x32x16_bf16(kf[2],qr[1],C0,0,0,0),   P0[10],P0[11],P0[12],P0[13], pw1[0]=PKW(P0,8), pw1[1]=PKW(P0,10), pw1); \
    VRD(5); SBAR(); GAPA(C1=__builtin_amdgcn_mfma_f32_32x32x16_bf16(kf[3],qr[1],C1,0,0,0),   P0[14],P0[15],P1[0],P1[1],   pw1[2]=PKW(P0,12),pw1[3]=PKW(P0,14), pw1); \
    VRD(2); SBAR(); GAPA(C0=__builtin_amdgcn_mfma_f32_32x32x16_bf16(kf[4],qr[2],C0,0,0,0),   P1[2],P1[3],P1[4],P1[5],     pw2[0]=PKW(P1,0), pw2[1]=PKW(P1,2), pw2); \
    VRD(6); SBAR(); GAPA(C1=__builtin_amdgcn_mfma_f32_32x32x16_bf16(kf[5],qr[2],C1,0,0,0),   P1[6],P1[7],P1[8],P1[9],     pw2[2]=PKW(P1,4), pw2[3]=PKW(P1,6), pw2); \
    VRD(3); SBAR(); GAPA(C0=__builtin_amdgcn_mfma_f32_32x32x16_bf16(kf[6],qr[3],C0,0,0,0),   P1[10],P1[11],P1[12],P1[13], pw3[0]=PKW(P1,8), pw3[1]=PKW(P1,10), pw3); \
    VRD(7); SBAR(); GAPA(C1=__builtin_amdgcn_mfma_f32_32x32x16_bf16(kf[7],qr[3],C1,0,0,0),   P1[14],P1[15],0.f,0.f,       pw3[2]=PKW(P1,12),pw3[3]=PKW(P1,14), pw3); \
    l_reg+=sacc; \
    if(GK){DMA_K((t)+3,sl_cur);} if(GV){DMA_V((t)+1,sl_next);} \
    if(!USE_NEGM){ if(__any(mhat!=0.f)){ _Pragma("unroll") for(int r=0;r<16;++r){C0[r]-=mhat;C1[r]-=mhat;} } } \
    CMASK(C0,C1,t); \
    { float a=MX3(C0[0],C0[1],C1[0]),b=MX3(C0[2],C0[3],C1[1]); a=MX3(a,C1[2],C1[3]); \
      _Pragma("unroll") for(int r=4;r<16;r+=4){a=MX3(a,C0[r],C0[r+1]);b=MX3(b,C0[r+2],C0[r+3]);a=MX3(a,C1[r],C1[r+1]);b=MX3(b,C1[r+2],C1[r+3]);} \
      float rm=__builtin_fmaxf(a,b); { auto rr=__builtin_amdgcn_permlane32_swap(__float_as_uint(rm),__float_as_uint(rm),false,false); rm=__builtin_fmaxf(__uint_as_float(rr[0]),__uint_as_float(rr[1])); } \
      resc=false; \
      if(__builtin_expect(__any(rm>(float)THRL),0)){ const float dl=__builtin_fmaxf(rm,0.f); mhat+=dl; \
        _Pragma("unroll") for(int r=0;r<16;++r){C0[r]-=dl;C1[r]-=dl;} \
        if(USE_NEGM){ _Pragma("unroll") for(int r=0;r<16;++r)negm[r]=-mhat; asm volatile("":"+v"(negm)); } \
        const float f=__builtin_amdgcn_exp2f(-dl); l_reg*=f; if(hi==0)wsf[r32]=f; resc=true; } } \
    SBAR(); \
    if(MODE!=1){ \
    GAPB(o[0]=__builtin_amdgcn_mfma_f32_32x32x16_bf16(PAF(0),VFR(0),o[0],0,0,0), C0,0); \
    GAPB(o[1]=__builtin_amdgcn_mfma_f32_32x32x16_bf16(PAF(0),VFR(4),o[1],0,0,0), C0,4); \
    KRD(GL,0); GAPB(o[0]=__builtin_amdgcn_mfma_f32_32x32x16_bf16(PAF(1),VFR(1),o[0],0,0,0), C0,8); \
    KRD(GL,1); GAPB(o[1]=__builtin_amdgcn_mfma_f32_32x32x16_bf16(PAF(1),VFR(5),o[1],0,0,0), C0,12); \
    KRD(GL,2); GAPB(o[0]=__builtin_amdgcn_mfma_f32_32x32x16_bf16(PAF(2),VFR(2),o[0],0,0,0), C1,0); \
    KRD(GL,3); GAPB(o[1]=__builtin_amdgcn_mfma_f32_32x32x16_bf16(PAF(2),VFR(6),o[1],0,0,0), C1,4); \
    GAPB(o[0]=__builtin_amdgcn_mfma_f32_32x32x16_bf16(PAF(3),VFR(3),o[0],0,0,0), C1,8); \
    GAPB(o[1]=__builtin_amdgcn_mfma_f32_32x32x16_bf16(PAF(3),VFR(7),o[1],0,0,0), C1,12); \
    } else {   \
    GAPB2(o[0]=__builtin_amdgcn_mfma_f32_32x32x16_bf16(PAF(0),VFR(0),o[0],0,0,0), C0,0);  VRD2(0); SBAR(); \
    GAPB2(o[1]=__builtin_amdgcn_mfma_f32_32x32x16_bf16(PAF(0),VFR(4),o[1],0,0,0), C0,2);  VRD2(4); SBAR(); \
    KRD(GL,0); GAPB2(o[0]=__builtin_amdgcn_mfma_f32_32x32x16_bf16(PAF(1),VFR(1),o[0],0,0,0), C0,4);  VRD2(1); SBAR(); \
    KRD(GL,1); GAPB2(o[1]=__builtin_amdgcn_mfma_f32_32x32x16_bf16(PAF(1),VFR(5),o[1],0,0,0), C0,6);  VRD2(5); SBAR(); \
    KRD(GL,2); GAPB2(o[0]=__builtin_amdgcn_mfma_f32_32x32x16_bf16(PAF(2),VFR(2),o[0],0,0,0), C0,8);  VRD2(2); SBAR(); \
    KRD(GL,3); GAPB2(o[1]=__builtin_amdgcn_mfma_f32_32x32x16_bf16(PAF(2),VFR(6),o[1],0,0,0), C0,10); VRD2(6); SBAR(); \
    GAPB2(o[0]=__builtin_amdgcn_mfma_f32_32x32x16_bf16(PAF(3),VFR(3),o[0],0,0,0), C0,12); VRD2(3); SBAR(); \
    GAPB2(o[1]=__builtin_amdgcn_mfma_f32_32x32x16_bf16(PAF(3),VFR(7),o[1],0,0,0), C0,14); VRD2(7); SBAR(); \
    GAPB2(o[NDQ-2]=__builtin_amdgcn_mfma_f32_32x32x16_bf16(PAF(0),VFR(0),o[NDQ-2],0,0,0), C1,0); \
    GAPB2(o[NDQ-1]=__builtin_amdgcn_mfma_f32_32x32x16_bf16(PAF(0),VFR(4),o[NDQ-1],0,0,0), C1,2); \
    GAPB2(o[NDQ-2]=__builtin_amdgcn_mfma_f32_32x32x16_bf16(PAF(1),VFR(1),o[NDQ-2],0,0,0), C1,4); \
    GAPB2(o[NDQ-1]=__builtin_amdgcn_mfma_f32_32x32x16_bf16(PAF(1),VFR(5),o[NDQ-1],0,0,0), C1,6); \
    GAPB2(o[NDQ-2]=__builtin_amdgcn_mfma_f32_32x32x16_bf16(PAF(2),VFR(2),o[NDQ-2],0,0,0), C1,8); \
    GAPB2(o[NDQ-1]=__builtin_amdgcn_mfma_f32_32x32x16_bf16(PAF(2),VFR(6),o[NDQ-1],0,0,0), C1,10); \
    GAPB2(o[NDQ-2]=__builtin_amdgcn_mfma_f32_32x32x16_bf16(PAF(3),VFR(3),o[NDQ-2],0,0,0), C1,12); \
    GAPB2(o[NDQ-1]=__builtin_amdgcn_mfma_f32_32x32x16_bf16(PAF(3),VFR(7),o[NDQ-1],0,0,0), C1,14); \
    } \
    }while(0)
  int t=1;
  #undef CMASK
  #define CMASK(P0,P1,t) do{}while(0)
  for(;(MODE==1)&&t+5<NT;t+=2){
    STEP(pB0,pB1,pA0,pA1,t,true,true,true);     WAIT_BAR(3); RESC(); ROT();
    STEP(pA0,pA1,pB0,pB1,t+1,true,true,true);   WAIT_BAR(3); RESC(); ROT();
  }
  #undef CMASK
  #define CMASK(P0,P1,t) HOOK(P0,P1,t)
  #define ENDW(tt) do{ if((tt)+3<NT){ if(MODE==1){WAIT_BAR(3);}else{WAIT_BAR(2);} } else if((tt)+2<NT){ if(MODE==1){WAIT_BAR(2);}else{WAIT_BAR(1);} } else {WAIT_BAR(0);} }while(0)
  for(;t+1<NT;t+=2){
    STEP(pB0,pB1,pA0,pA1,t,(t+3<NT),(t+1<NT),(t+1<NT));       ENDW(t);   RESC(); ROT();
    STEP(pA0,pA1,pB0,pB1,t+1,(t+4<NT),(t+2<NT),(t+2<NT));     ENDW(t+1); RESC(); ROT();
  }
  STEP(pB0,pB1,pA0,pA1,NT-1,false,false,false); RESC();
  { float sacc=pB0[0]+pB0[1]; _Pragma("unroll") for(int r=2;r<16;++r)sacc+=pB0[r]; _Pragma("unroll") for(int r=0;r<16;++r)sacc+=pB1[r]; l_reg+=sacc;
    pw0=(u32x4){PKW(pB0,0),PKW(pB0,2),PKW(pB0,4),PKW(pB0,6)};pw1=(u32x4){PKW(pB0,8),PKW(pB0,10),PKW(pB0,12),PKW(pB0,14)};pw2=(u32x4){PKW(pB1,0),PKW(pB1,2),PKW(pB1,4),PKW(pB1,6)};pw3=(u32x4){PKW(pB1,8),PKW(pB1,10),PKW(pB1,12),PKW(pB1,14)};
    SBAR(); pv<NDQ>(o,vb0+VSL*sl_cur,PAF(0),PAF(1),PAF(2),PAF(3)); }
  #undef PKW
  #undef PAF
  #undef VFR
  #undef PIN
  #undef MX3
  #undef GAPA
  #undef GAPB
  #undef EX
  #undef VRD
  #undef VRD2
  #undef GAPB2
  #undef KRD
  #undef STEP
  #undef ENDW
  {auto rr=__builtin_amdgcn_permlane32_swap(__float_as_uint(l_reg),__float_as_uint(l_reg),false,false);l_reg=__uint_as_float(rr[0])+__uint_as_float(rr[1]);}
  if(hi==0)wsf[32+r32]=l_reg;asm volatile("s_waitcnt lgkmcnt(0)":::"memory");
  float rli[16];
  #pragma unroll
  for(int r=0;r<16;++r)rli[r]=__builtin_amdgcn_rcpf(wsf[32+crow(r,hi)]);
  bf16*Ow=Oc+(rowbase+q0+wid*QBLK)*POUT;
  { bf16*stg=(bf16*)(shm+LDS_OST)+wid*2048;
    int tz_=threadIdx.x; asm volatile("":"+v"(tz_)); const int lz=tz_&63;
    #pragma unroll
    for(int hh_=0;hh_<NDQ/2;++hh_){
      #pragma unroll
      for(int r=0;r<16;++r){const int orow=crow(r,hi);
        #pragma unroll
        for(int d0=0;d0<2;++d0)stg[orow*64+d0*32+r32]=__float2bfloat16(o[2*hh_+d0][r]*rli[r]);}
      asm volatile("s_waitcnt lgkmcnt(0)":::"memory");
      #pragma unroll
      for(int i=0;i<4;++i){const int row=i*8+(lz>>3),ch=lz&7; const u32x4 v=*(const u32x4*)(stg+row*64+ch*8); ATTN_STORE16(Ow+(long)row*POUT+hh_*64+ch*8,v);}
      asm volatile("s_waitcnt lgkmcnt(0)":::"memory"); } }
  asm volatile("s_waitcnt lgkmcnt(0)\n\ts_barrier":::"memory");
  #undef DMA_K
  #undef DMA_V
  #undef CMASK
  #undef HOOK
  #undef TIDX
  #undef START
  #undef RESC
  #undef ROT
}
constexpr int ATTN_LDS_BYTES=LDS_BYTES;
#undef SBAR
#undef WAIT_BAR
}


constexpr int N_BUNITS = NB * 8 * 16, N_AUNITS = NB * 8 * 16;
__device__ __forceinline__ void run_chunks(CtxK& C, LAS unsigned char* lds, const int cwc) {
    const int tid = hid_tid(), wave = __builtin_amdgcn_readfirstlane(tid >> 6), lane = tid & 63;
    unsigned* ctl = WSP(unsigned, WS_CTL);
    LAS int* tk = (LAS int*)(lds + L_MISC);
    LAS f32x4* exch = (LAS f32x4*)(lds + L_EP);
    if (tid == 0) tk[0] = (int)__hip_atomic_fetch_add(ctl + cwc, 1u, __ATOMIC_RELAXED, __HIP_MEMORY_SCOPE_AGENT);
    __syncthreads();
    int cur = __builtin_amdgcn_readfirstlane(tk[0]), par = 1;
    if (cur < N_SCHUNKS) chunk_dma<0>(C, lds, cur, wave, lane); else if (cur < N_SCHUNKS + N_ZCHUNKS) chunk_dma<1>(C, lds, cur - N_SCHUNKS, wave, lane);
    while (cur < N_SCHUNKS + N_ZCHUNKS) {
        int nx = 0; if (tid == 0) nx = (int)__hip_atomic_fetch_add(ctl + cwc, 1u, __ATOMIC_RELAXED, __HIP_MEMORY_SCOPE_AGENT);
        asm volatile("s_waitcnt vmcnt(0)" ::: "memory");
        f32x4 lo[8], hi[8]; chunk_read(lo, hi, lds, wave, lane);
        const f32x4 m = __builtin_elementwise_max(colmax_regs(lo), colmax_regs(hi));
        if (lane < 8) exch[par * 64 + wave * 8 + lane] = m;
        if (tid == 0) tk[par] = nx;
        __syncthreads();
        const int nxt = __builtin_amdgcn_readfirstlane(tk[par]);
        if (nxt < N_SCHUNKS) chunk_dma<0>(C, lds, nxt, wave, lane); else if (nxt < N_SCHUNKS + N_ZCHUNKS) chunk_dma<1>(C, lds, nxt - N_SCHUNKS, wave, lane);
        f32x4 cm = exch[par * 64 + (lane & 7)];
#pragma unroll
        for (int w8 = 1; w8 < 8; ++w8) cm = __builtin_elementwise_max(cm, exch[par * 64 + w8 * 8 + (lane & 7)]);
        if (cur < N_SCHUNKS) chunk_emit<0>(C, lo, hi, cm, cur, wave, lane); else chunk_emit<1>(C, lo, hi, cm, cur - N_SCHUNKS, wave, lane);
        cur = nxt; par ^= 1;
    }
    asm volatile("s_waitcnt vmcnt(0)" ::: "memory");
    __syncthreads();
}
__device__ __forceinline__ void phase_attn(CtxK& C, unsigned char* lds_gen, LAS unsigned char* lds, const int cwb0 = CW_QB, const int cwa = CW_QA, const int cwc = CW_QC) {
    static_assert(attn_body::ATTN_LDS_BYTES <= RING_BYTES, "attention scratch fits the ring region");
    const bool conv_first = ((blockIdx.x >> 3) & 7) >= 5;
    if (conv_first) run_chunks(C, lds, cwc);
    const int tid = hid_tid();
    unsigned* ctl = WSP(unsigned, WS_CTL);
    LAS int* tk = (LAS int*)(lds + L_MISC);
    const attn_body::bf16* PQ = (const attn_body::bf16*)WSP(bf16_t, WS_PQ);
    attn_body::bf16* OC = (attn_body::bf16*)WSP(bf16_t, WS_OC); attn_body::bf16* MIX = (attn_body::bf16*)WSP(bf16_t, WS_MIX);
    for (int brep = 0; brep < ((PROBE_DBL & 32768) ? 2 : 1); ++brep) {
    const int cwb = cwb0 + 512 * brep;
    if (tid == 0) tk[0] = (int)__hip_atomic_fetch_add(ctl + cwb, 1u, __ATOMIC_RELAXED, __HIP_MEMORY_SCOPE_AGENT);
    __syncthreads();
    for (;;) {
        const int cur = __builtin_amdgcn_readfirstlane(tk[0]);
        if (cur >= N_BUNITS) break;
        int nxt = 0; if (tid == 0) nxt = (int)__hip_atomic_fetch_add(ctl + cwb, 1u, __ATOMIC_RELAXED, __HIP_MEMORY_SCOPE_AGENT);
        const int qb = 15 - (cur >> 5), j = cur & 31, b = j >> 3, hh = (j >> 1) & 3, comp = j & 1;
        attn_body::attn_unit<1, 8>(b, qb, PQ + COL_QB + hh * 128 + comp * 64, PQ + COL_KB + hh * 128 + comp * 64, PQ + COL_VB + hh * 128,
                                   OC + comp * 512 + hh * 128, nullptr, (char*)lds_gen + RING_OFF);
        if (tid == 0) tk[0] = nxt;
        __syncthreads();
    }
    __syncthreads();
    }
    if (tid == 0) tk[0] = (int)__hip_atomic_fetch_add(ctl + cwa, 1u, __ATOMIC_RELAXED, __HIP_MEMORY_SCOPE_AGENT);
    __syncthreads();
    for (;;) {
        const int cur = __builtin_amdgcn_readfirstlane(tk[0]);
        if (cur >= N_AUNITS) break;
        int nxt = 0; if (tid == 0) nxt = (int)__hip_atomic_fetch_add(ctl + cwa, 1u, __ATOMIC_RELAXED, __HIP_MEMORY_SCOPE_AGENT);
        const int qb = 15 - (cur >> 5), j = cur & 31, b = j >> 3, h = j & 7;
        attn_body::attn_unit<0, 8>(b, qb, PQ + COL_QA + h * 64, PQ + COL_KA + h * 64, PQ + COL_VA + h * 64, MIX + h * 64, C.rel_bias + h * 257, (char*)lds_gen + RING_OFF);
        if (tid == 0) tk[0] = nxt;
        __syncthreads();
    }
    __syncthreads();
    if (!conv_first) run_chunks(C, lds, cwc);
}
__device__ __forceinline__ void phase_combine(CtxK& C, int gw, int ngw, int lane) {
    const float lam = expf(wave_sum(C.lq1[lane] * C.lk1[lane])) - expf(wave_sum(C.lq2[lane] * C.lk2[lane])) + LAMBDA_INIT;
    const bf16_t* OC = WSP(bf16_t, WS_OC); const bf16_t* MIX = WSP(bf16_t, WS_MIX); unsigned char* MIX8 = WSP(unsigned char, WS_MIX8); float* sam = WSP(float, WS_SAM);
    const int d0 = (lane & 15) * 8;
    float g[8];
#pragma unroll
    for (int i = 0; i < 8; ++i) g[i] = C.g_subln[d0 + i] * (1.f - LAMBDA_INIT);
    constexpr int R = 2;
    for (int row0 = gw; row0 < NTOK; row0 += R * ngw) {
        u32x4 av[R], bv[R], qv[R];
#pragma unroll
        for (int u = 0; u < R; ++u) { const int row = (row0 + u * ngw < NTOK) ? row0 + u * ngw : row0;
            av[u] = *(const u32x4*)(OC + (size_t)row * DM + lane * 8); bv[u] = *(const u32x4*)(OC + (size_t)row * DM + 512 + lane * 8); qv[u] = *(const u32x4*)(MIX + (size_t)row * DM + lane * 8); }
        asm volatile("" : "+v"(av[0]), "+v"(av[1]), "+v"(bv[0]), "+v"(bv[1]), "+v"(qv[0]), "+v"(qv[1]));
#pragma unroll
        for (int u = 0; u < R; ++u) { const int row = row0 + u * ngw; if (row < NTOK) {
        const u32x4 a = av[u], bq = bv[u];
        float y[8]; float ss = 0.f;
#pragma unroll
        for (int i = 0; i < 4; ++i) { const unsigned ua = a[i], ub = bq[i];
            y[2 * i] = __uint_as_float(ua << 16) - lam * __uint_as_float(ub << 16); y[2 * i + 1] = __uint_as_float(ua & 0xffff0000u) - lam * __uint_as_float(ub & 0xffff0000u);
            ss += y[2 * i] * y[2 * i] + y[2 * i + 1] * y[2 * i + 1]; }
        ss = row_sum(ss);
        const float rstd = rsqrtf(ss * (1.f / 128.f) + EPS);
        const u32x4 aq = qv[u]; float xa[8], yb[8]; float am = 0.f;
#pragma unroll
        for (int i = 0; i < 4; ++i) { xa[2 * i] = __uint_as_float(aq[i] << 16); xa[2 * i + 1] = __uint_as_float(aq[i] & 0xffff0000u); }
#pragma unroll
        for (int i = 0; i < 8; ++i) { yb[i] = y[i] * rstd * g[i]; am = fmaxf(am, fmaxf(fabsf(xa[i]), fabsf(yb[i]))); }
        am = wave_max(am); const float inv = am > 0.f ? 127.f / am : 0.f;
        f32x2 oa, ob; oa.x = __uint_as_float(pack_q8(xa[0], xa[1], xa[2], xa[3], inv)); oa.y = __uint_as_float(pack_q8(xa[4], xa[5], xa[6], xa[7], inv));
        ob.x = __uint_as_float(pack_q8(yb[0], yb[1], yb[2], yb[3], inv)); ob.y = __uint_as_float(pack_q8(yb[4], yb[5], yb[6], yb[7], inv));
        *(f32x2*)(MIX8 + (size_t)row * DM + lane * 8) = oa; *(f32x2*)(MIX8 + (size_t)row * DM + 512 + lane * 8) = ob;
        if (lane == 0) sam[row] = am * (1.f / 127.f);
        } }
    }
}

#define XB_TMO      128
#define XB_XCNT(j)  (256  + 64 * (j))
#define XB_XSUB(j)  (1280 + 64 * (j))
#define XB_XGEN(j)  (2304 + 64 * (j))
#define XB_TOP      3328
#define XB_TOPGEN   3392
#define XCD_BAR_WORDS 3456
#define XB_SPIN_CAP (1u << 18)

__device__ __forceinline__ unsigned xb_ld(unsigned* p)              { return __hip_atomic_load(p, __ATOMIC_RELAXED, __HIP_MEMORY_SCOPE_AGENT); }
__device__ __forceinline__ unsigned xb_add(unsigned* p, unsigned v) { return __hip_atomic_fetch_add(p, v, __ATOMIC_RELAXED, __HIP_MEMORY_SCOPE_AGENT); }
__device__ __forceinline__ unsigned xb_xcc_id() { return (unsigned)__builtin_amdgcn_s_getreg((3 << 11) | 20) & 0xFu; }
#define XB_SPIN(cond, bar) do { unsigned _sp = 0; while (cond) { __builtin_amdgcn_s_sleep(1); \
    if ((++_sp & 255u) == 0u) { if (xb_ld(&(bar)[XB_TMO])) break; if (_sp > XB_SPIN_CAP) { atomicAdd(&(bar)[XB_TMO], 1u); break; } } } } while (0)

struct XcdBarrier {
    unsigned* bar; unsigned x;
    volatile LAS unsigned* st;
};

__device__ __forceinline__ XcdBarrier xcd_barrier_post(unsigned* bar, volatile LAS unsigned* st) {
    XcdBarrier b; b.bar = bar; b.x = xb_xcc_id(); b.st = st;
    if (threadIdx.x == 0) (void)xb_add(&bar[XB_XCNT(b.x)], 1u);
    return b;
}
__device__ __forceinline__ void xcd_barrier_complete(unsigned* bar, unsigned x, unsigned& nloc, unsigned& nx) {
    const unsigned G = gridDim.x * gridDim.y * gridDim.z;
    unsigned sum, cnt, mine, sp = 0u;
    for (;;) {
        sum = 0u; cnt = 0u; mine = 0u;
#pragma unroll
        for (unsigned j = 0; j < 16; ++j) { const unsigned c = xb_ld(&bar[XB_XCNT(j)]); sum += c; cnt += (c > 0u) ? 1u : 0u; mine = (j == x) ? c : mine; }
        if (sum == G) break;
        __builtin_amdgcn_s_sleep(1);
        if ((++sp & 255u) == 0u) { if (xb_ld(&bar[XB_TMO])) break; if (sp > XB_SPIN_CAP) { atomicAdd(&bar[XB_TMO], 1u); break; } }
    }
    nloc = mine > 0u ? mine : 1u; nx = cnt > 0u ? cnt : 1u;
}

__device__ __forceinline__ void xcd_barrier(const XcdBarrier& b) {
    asm volatile("s_waitcnt vmcnt(0)" ::: "memory");
    __syncthreads();
    if (threadIdx.x == 0) {
        unsigned* bar = b.bar;
        __builtin_amdgcn_s_waitcnt(0);
        unsigned nloc = b.st[0], nx = b.st[1];
        if (nloc == 0u) { xcd_barrier_complete(bar, b.x, nloc, nx); b.st[0] = nloc; b.st[1] = nx; }
        const unsigned old = xb_add(&bar[XB_XSUB(b.x)], 1u);
        const unsigned gen = old / nloc;
        if (old + 1u == (gen + 1u) * nloc) {
            __builtin_amdgcn_fence(__ATOMIC_RELEASE, "agent");
            asm volatile("s_waitcnt vmcnt(0)" ::: "memory");
            const unsigned og = xb_add(&bar[XB_TOP], 1u);
            const unsigned tg = og / nx;
            if (og + 1u == (tg + 1u) * nx) xb_add(&bar[XB_TOPGEN], 1u);
            else XB_SPIN(xb_ld(&bar[XB_TOPGEN]) == tg, bar);
            __builtin_amdgcn_fence(__ATOMIC_ACQUIRE, "agent");
            xb_add(&bar[XB_XGEN(b.x)], 1u);
            asm volatile("s_waitcnt vmcnt(0)" ::: "memory");
        } else {
            XB_SPIN(xb_ld(&bar[XB_XGEN(b.x)]) == gen, bar);
            __builtin_amdgcn_fence(__ATOMIC_ACQUIRE, "agent");
            asm volatile("s_waitcnt vmcnt(0)" ::: "memory");
        }
    }
    __syncthreads();
}

__device__ __forceinline__ void phase_mod_partials(CtxK& C, int gw, int ngw, int lane) {
    float* part = WSP(float, WS_MODP);
    for (int it = gw; it < 96 * MODP_KC; it += ngw) {
        const int jb = it % 96, kc = it / 96, j = jb * 64 + lane, k0 = kc * 64;
        float sv[4], acc[4];
#pragma unroll
        for (int b = 0; b < 4; ++b) sv[b] = C.c[b * DM + k0 + lane];
        asm volatile("" : "+v"(sv[0]), "+v"(sv[1]), "+v"(sv[2]), "+v"(sv[3]));
#pragma unroll
        for (int b = 0; b < 4; ++b) { const float cv = sv[b]; sv[b] = cv / (1.f + expf(-cv)); acc[b] = 0.f; }
        const float* wp = C.w_ada + (size_t)k0 * (6 * DM) + j;
        float wv_[64];
#pragma unroll
        for (int kk = 0; kk < 64; ++kk) wv_[kk] = wp[(size_t)kk * (6 * DM)];
#pragma unroll
        for (int kk = 0; kk < 64; ++kk) {
#pragma unroll
            for (int b = 0; b < 4; ++b) acc[b] += __int_as_float(__builtin_amdgcn_readlane(__float_as_int(sv[b]), kk)) * wv_[kk]; }
#pragma unroll
        for (int b = 0; b < 4; ++b) part[(size_t)(kc * 4 + b) * (6 * DM) + j] = acc[b];
    }
}
__device__ __forceinline__ void phase_rope_misc(CtxK& C, int gt, int nt) {
    float* rope = WSP(float, WS_ROPE);
    for (int idx = gt; idx < NTOK * 8; idx += nt) {
        const int row = idx >> 3, i = idx & 7;
        float f = 1.0f;
        f = (i == 1) ? 0.1939227432012558f : f; f = (i == 2) ? 0.03760603070259094f : f; f = (i == 3) ? 0.007292664609849453f : f; f = (i == 4) ? 0.0014142135623842478f : f;
        f = (i == 5) ? 0.00027424818836152554f : f; f = (i == 6) ? 5.3182957344688475e-05f : f; f = (i == 7) ? 1.0313385246263351e-05f : f;
        const float ang = (float)C.positions[row] * f;
        rope[2 * idx] = cosf(ang); rope[2 * idx + 1] = sinf(ang);
    }
    int* ts = WSP(int, WS_TOKSLOT);
    for (int idx = gt; idx < NSLOT_MAX; idx += nt) ts[idx] = 0;
    for (int idx = gt; idx < NE * (DM / 8); idx += nt) { const int e = idx & 31, ko = idx >> 5; float w[8];
#pragma unroll
        for (int j = 0; j < 8; ++j) w[j] = C.w_router[(size_t)(8 * ko + j) * NE + e];
        u32x4 o; o.x = pg8::cvt_pk_bf16(w[0], w[1]); o.y = pg8::cvt_pk_bf16(w[2], w[3]); o.z = pg8::cvt_pk_bf16(w[4], w[5]); o.w = pg8::cvt_pk_bf16(w[6], w[7]);
        *(u32x4*)(WSP(bf16_t, WS_WRT) + (size_t)e * DM + 8 * ko) = o; }

}
__device__ __forceinline__ float mod_reduce(CtxK& C, int b, int j) {
    const float* part = WSP(float, WS_MODP); float s = C.b_ada[j];
#pragma unroll
    for (int kc = 0; kc < MODP_KC; ++kc) s += part[(size_t)(kc * 4 + b) * (6 * DM) + j];
    return s;
}
__device__ __forceinline__ void phase_norm1(CtxK& C, LAS unsigned char* lds) {
    const int tid = hid_tid(), lane = tid & 63, wv = tid >> 6;
    LAS float* shs = (LAS float*)(lds + RING_OFF);
    float* mod = WSP(float, WS_MOD); unsigned char* H8 = WSP(unsigned char, WS_H8); float* sa = WSP(float, WS_SA);
    for (int blk = blockIdx.x; blk < NTOK / 64; blk += gridDim.x) {
        const int b = (blk * 64) / SEQ;
        if (tid < 96) { const int idx = blk * 96 + tid; mod[idx] = mod_reduce(C, idx / (6 * DM), idx % (6 * DM)); }
#pragma unroll
        for (int i = 0; i < 4; ++i) { const int j = tid + 512 * i; shs[j] = mod_reduce(C, b, j); }
        __syncthreads();
        for (int hf = 0; hf < 2; ++hf) {
            const int row0 = blk * 64 + wv * 8 + hf * 4; f32x4 v[4][4];
#pragma unroll
            for (int i = 0; i < 4; ++i)
#pragma unroll
                for (int j = 0; j < 4; ++j) v[i][j] = ((const f32x4*)(C.x + (size_t)(row0 + i) * DM))[lane + 64 * j];
            f32x4 gs[4], sh[4];
#pragma unroll
            for (int j = 0; j < 4; ++j) { const int col = 4 * lane + 256 * j; gs[j] = *(const f32x4*)(C.g_mix + col) * (*(const LAS f32x4*)(shs + DM + col) + 1.f); sh[j] = *(const LAS f32x4*)(shs + col); }
#pragma unroll
            for (int i = 0; i < 4; ++i) { float ss = 0.f;
#pragma unroll
                for (int j = 0; j < 4; ++j) ss += v[i][j].x * v[i][j].x + v[i][j].y * v[i][j].y + v[i][j].z * v[i][j].z + v[i][j].w * v[i][j].w;
                const float rstd = rsqrtf(wave_sum(ss) * (1.f / DM) + EPS); float am = 0.f;
#pragma unroll
                for (int j = 0; j < 4; ++j) { v[i][j] = v[i][j] * rstd * gs[j] + sh[j]; const f32x4 a = __builtin_elementwise_abs(v[i][j]); am = fmaxf(fmaxf(am, fmaxf(a.x, a.y)), fmaxf(a.z, a.w)); }
                am = wave_max(am); const float inv = am > 0.f ? 127.f / am : 0.f;
#pragma unroll
                for (int j = 0; j < 4; ++j) *(unsigned*)(H8 + (size_t)(row0 + i) * DM + 4 * lane + 256 * j) = pack_q8(v[i][j].x, v[i][j].y, v[i][j].z, v[i][j].w, inv);
                if (lane == 0) sa[row0 + i] = am * (1.f / 127.f); }
        }
        __syncthreads();
    }
}
typedef float rt_f32x16 __attribute__((ext_vector_type(16)));
__device__ __forceinline__ void phase_route(CtxK& C, LAS unsigned char* lds) {
    LAS int* sel = (LAS int*)(lds + L_SEL);
    const int tid = hid_tid(), lane = tid & 63, wv = tid >> 6;
    LAS unsigned char* hb = lds + RING_OFF;
    LAS float* hs = (LAS float*)(lds + RING_OFF);
    const bf16_t* X1 = WSP(bf16_t, WS_X1); const float* mod = WSP(float, WS_MOD); unsigned char* H8F = WSP(unsigned char, WS_H8F); float* saf = WSP(float, WS_SAF);
    int* tope = WSP(int, WS_TOPE); float* topw = WSP(float, WS_TOPW); int* lrank = WSP(int, WS_LRANK); int* hist = WSP(int, WS_HIST);
    for (int g = blockIdx.x; g < NGRP; g += gridDim.x) {
        bf16x8 wf[8];
        { const bf16_t* wt = WSP(bf16_t, WS_WRT) + (size_t)(lane & 31) * DM + wv * 128 + 8 * (lane >> 5);
#pragma unroll
            for (int ks = 0; ks < 8; ++ks) wf[ks] = *(const bf16x8*)(wt + 16 * ks); }
        float br_pre = C.b_router[lane & 31]; asm volatile("" : "+v"(br_pre));
        f32x4 g4[4], sh[4];
        { const int b = (g * 64) / SEQ; f32x4 sc[4];
#pragma unroll
            for (int j = 0; j < 4; ++j) { const int col = 4 * lane + 256 * j; g4[j] = *(const f32x4*)(C.g_ffn + col);
                sh[j] = *(const f32x4*)(mod + b * 6 * DM + 3 * DM + col); sc[j] = *(const f32x4*)(mod + b * 6 * DM + 4 * DM + col); }
#pragma unroll
            for (int j = 0; j < 4; ++j) g4[j] = g4[j] * (sc[j] + 1.f); }
        for (int ps = 0; ps < 2; ++ps) {
            { const int t0 = g * 64 + wv * 8 + ps * 4;
                f32x4 v[4][4];
                f32x2 rw[4][4];
#pragma unroll
                for (int i = 0; i < 4; ++i)
#pragma unroll
                    for (int j = 0; j < 4; ++j) rw[i][j] = ((const f32x2*)(X1 + (size_t)(t0 + i) * DM))[lane + 64 * j];
                asm volatile("" : "+v"(rw[0][0]), "+v"(rw[0][1]), "+v"(rw[0][2]), "+v"(rw[0][3]), "+v"(rw[1][0]), "+v"(rw[1][1]), "+v"(rw[1][2]), "+v"(rw[1][3]),
                                  "+v"(rw[2][0]), "+v"(rw[2][1]), "+v"(rw[2][2]), "+v"(rw[2][3]), "+v"(rw[3][0]), "+v"(rw[3][1]), "+v"(rw[3][2]), "+v"(rw[3][3]));
#pragma unroll
                for (int i = 0; i < 4; ++i)
#pragma unroll
                    for (int j = 0; j < 4; ++j) { const unsigned u0 = __float_as_uint(rw[i][j].x), u1 = __float_as_uint(rw[i][j].y);
                        v[i][j] = (f32x4){__uint_as_float(u0 << 16), __uint_as_float(u0 & 0xffff0000u), __uint_as_float(u1 << 16), __uint_as_float(u1 & 0xffff0000u)}; }
#pragma unroll
                for (int i = 0; i < 4; ++i) { float ss = 0.f;
#pragma unroll
                    for (int j = 0; j < 4; ++j) ss += v[i][j].x * v[i][j].x + v[i][j].y * v[i][j].y + v[i][j].z * v[i][j].z + v[i][j].w * v[i][j].w;
                    const float rstd = rsqrtf(wave_sum(ss) * (1.f / DM) + EPS);
                    const int tl = wv * 8 + ps * 4 + i;
                    float am = 0.f;
#pragma unroll
                    for (int j = 0; j < 4; ++j) {
                        const f32x4 y = v[i][j] * rstd * g4[j] + sh[j]; v[i][j] = y;
                        f32x2 pk; pk.x = __uint_as_float(pg8::cvt_pk_bf16(y.x, y.y)); pk.y = __uint_as_float(pg8::cvt_pk_bf16(y.z, y.w));
                        *(LAS f32x2*)(hb + tl * 2048 + (((((lane >> 1) + 32 * j)) ^ (tl & 15)) << 4) + (lane & 1) * 8) = pk;
                        const f32x4 a = __builtin_elementwise_abs(y); am = fmaxf(fmaxf(am, fmaxf(a.x, a.y)), fmaxf(a.z, a.w)); }
#pragma unroll
                    for (int j = 0; j < 4; ++j) { const f32x4 c = __builtin_elementwise_min(__builtin_elementwise_max(v[i][j], (f32x4){-448.f, -448.f, -448.f, -448.f}), (f32x4){448.f, 448.f, 448.f, 448.f});
                        *(unsigned*)(H8F + (size_t)(t0 + i) * DM + 4 * lane + 256 * j) = pack_f8(c.x, c.y, c.z, c.w, 1.f); }
                    (void)am; }
            }
        }
        __syncthreads();
        rt_f32x16 acc0, acc1;
#pragma unroll
        for (int r = 0; r < 16; ++r) { acc0[r] = 0.f; acc1[r] = 0.f; }
        { const int tk = lane & 31, sw = tk & 15; const LAS unsigned char* ha = hb + tk * 2048;
#pragma unroll
            for (int ks = 0; ks < 8; ++ks) { const int c = wv * 16 + 2 * ks + (lane >> 5);
                const bf16x8 a0 = *(const LAS bf16x8*)(ha + ((c ^ sw) << 4)), a1 = *(const LAS bf16x8*)(ha + 32 * 2048 + ((c ^ sw) << 4));
                acc0 = __builtin_amdgcn_mfma_f32_32x32x16_bf16(a0, wf[ks], acc0, 0, 0, 0); acc1 = __builtin_amdgcn_mfma_f32_32x32x16_bf16(a1, wf[ks], acc1, 0, 0, 0); } }
        __syncthreads();
        { LAS float* pp = hs + wv * 2048 + (lane & 31);
#pragma unroll
            for (int r = 0; r < 16; ++r) { const int tk = (r & 3) + 8 * (r >> 2) + 4 * (lane >> 5); pp[tk * 32] = acc0[r]; pp[(32 + tk) * 32] = acc1[r]; } }
        __syncthreads();
        { const int l2 = hid_tid() & 63, e = l2 & 31, hf = l2 >> 5; const float br = br_pre;
            LAS float* fin = (LAS float*)(lds + RING_OFF + 65536) + wv * 256;
            LAS float* tkv = (LAS float*)(lds + RING_OFF + 65536 + 8192) + wv * 64;
#pragma unroll
            for (int pi = 0; pi < 4; ++pi) {
                const int q = 2 * pi + hf, tp = wv * 8 + q;
                float lg = br;
#pragma unroll
                for (int w8 = 0; w8 < 8; ++w8) lg += hs[w8 * 2048 + tp * 32 + e];
                fin[q * 32 + e] = lg;
            }
            __builtin_amdgcn_wave_barrier();
#pragma unroll
            for (int pi = 0; pi < 4; ++pi) {
                const int q = 2 * pi + hf; const float mine = fin[q * 32 + e]; int rank = 0;
                int neq = 0;
#pragma unroll
                for (int j4 = 0; j4 < 8; ++j4) { const f32x4 o = *(const LAS f32x4*)(fin + q * 32 + 4 * j4);
#pragma unroll
                    for (int c = 0; c < 4; ++c) { rank += (o[c] > mine) ? 1 : 0; neq += (o[c] == mine) ? 1 : 0; } }
                if (__builtin_expect(__any(neq > 1), 0)) {
#pragma unroll
                    for (int j4 = 0; j4 < 8; ++j4) { const f32x4 o = *(const LAS f32x4*)(fin + q * 32 + 4 * j4);
#pragma unroll
                        for (int c = 0; c < 4; ++c) { const int j = 4 * j4 + c; rank += (o[c] == mine && j < e) ? 1 : 0; } } }
                if (rank < 4) { tkv[q * 4 + rank] = mine; ((LAS int*)tkv)[32 + q * 4 + rank] = e; }
            }
            __builtin_amdgcn_wave_barrier();
            if (l2 < 32) { const int q = l2 >> 2, k = l2 & 3, tl = wv * 8 + q, t = g * 64 + tl;
                const f32x4 tv = *(const LAS f32x4*)(tkv + q * 4); const int ei = ((const LAS int*)tkv)[32 + q * 4 + k] & (NE - 1);
                const float e0 = 1.f, e1 = __expf(tv[1] - tv[0]), e2 = __expf(tv[2] - tv[0]), e3 = __expf(tv[3] - tv[0]); const float es = ((e0 + e1) + e2) + e3;
                const float mine = (k == 0) ? e0 : (k == 1) ? e1 : (k == 2) ? e2 : e3;
                tope[t * 4 + k] = ei; topw[t * 4 + k] = __fdividef(mine, es); sel[tl * 4 + k] = ei; }
        }
        __syncthreads();
        { const int l2 = hid_tid() & 63; const i32x4 se = *(const LAS i32x4*)(sel + l2 * 4);
#pragma unroll
            for (int ee = 0; ee < 4; ++ee) { const int e = wv * 4 + ee;
                const bool h0 = se.x == e, h1 = se.y == e, h2 = se.z == e, h3 = se.w == e; const bool has = h0 | h1 | h2 | h3;
                const unsigned long long m = __ballot(has);
                const int r = (int)__builtin_amdgcn_mbcnt_hi((unsigned)(m >> 32), __builtin_amdgcn_mbcnt_lo((unsigned)m, 0u));
                if (has) lrank[(g * 64 + l2) * 4 + (h1 ? 1 : (h2 ? 2 : (h3 ? 3 : 0)))] = r;
                if (l2 == 0) hist[g * NE + e] = (int)__builtin_popcountll(m); }
        }
        __syncthreads();
    }
}
__device__ __forceinline__ void phase_slots(CtxK& C, LAS unsigned char* lds) {
    const int tid = hid_tid();
    const int* hist = WSP(int, WS_HIST); const int* tope = WSP(int, WS_TOPE); const float* topw = WSP(float, WS_TOPW); const int* lrank = WSP(int, WS_LRANK);
    int* pos = WSP(int, WS_POS); int* tokslot = WSP(int, WS_TOKSLOT); float* wslot = WSP(float, WS_WSLOT); float* sas = WSP(float, WS_SAS); const float* saf = WSP(float, WS_SAF);
    int pe = 0, plr = 0; float pw = 0.f;
    if (tid < 256) { const int idx = ((int)blockIdx.x * 64 + (tid >> 2)) * 4 + (tid & 3); pe = tope[idx]; plr = lrank[idx]; pw = topw[idx]; }
    moe_tables(hist, lds, (int)blockIdx.x);
    const LAS int* poff = (const LAS int*)(lds + L_POFF); const LAS int* part = (const LAS int*)(lds + L_PART); LAS int* goff = (LAS int*)(lds + L_GOFF);
    for (int g = blockIdx.x; g < NGRP; g += gridDim.x) {
        if (tid < NE) { int s = poff[tid]; const int pb = g >> 4;
            for (int p = 0; p < pb; ++p) s += part[p * NE + tid];
            if (g == (int)blockIdx.x) s += ((const LAS int*)(lds + L_LG))[tid];
            else for (int q = pb * 16; q < g; ++q) s += hist[q * NE + tid];
            goff[tid] = s; }
        __syncthreads();
        if (tid < 256) { const int idx = (g * 64 + (tid >> 2)) * 4 + (tid & 3); const bool first = (g == (int)blockIdx.x);
            const int e = first ? pe : tope[idx]; const int slot = goff[e] + (first ? plr : lrank[idx]);
            pos[idx] = slot; tokslot[slot] = g * 64 + (tid >> 2); wslot[slot] = first ? pw : topw[idx]; }
        __syncthreads();
    }
}
__device__ __forceinline__ void phase_final(CtxK& C, int gw, int ngw, int lane) {
    const bf16_t* X1 = WSP(bf16_t, WS_X1); const float* mod = WSP(float, WS_MOD); const unsigned char* Y = WSP(unsigned char, WS_Y); const int* pos = WSP(int, WS_POS); const float* topw = WSP(float, WS_TOPW);
    constexpr int U = 2;
    f32x4 gfin[4];
#pragma unroll
    for (int j = 0; j < 4; ++j) gfin[j] = *(const f32x4*)(C.g_final + 4 * lane + 256 * j);
    asm volatile("" : "+v"(gfin[0]), "+v"(gfin[1]), "+v"(gfin[2]), "+v"(gfin[3]));
    for (int r0 = gw; r0 < NTOK; r0 += U * ngw) {
        int p[U][4]; float wk[U][4];
#pragma unroll
        for (int u = 0; u < U; ++u) { const int row = (r0 + u * ngw < NTOK) ? r0 + u * ngw : r0;
#pragma unroll
            for (int k = 0; k < 4; ++k) { p[u][k] = pos[row * 4 + k]; wk[u][k] = topw[row * 4 + k]; } }
        int yy[U][4][4]; f32x2 raw[U][4]; f32x4 gtv[U][4];
#pragma unroll
        for (int u = 0; u < U; ++u) { const int row = (r0 + u * ngw < NTOK) ? r0 + u * ngw : r0;
#pragma unroll
            for (int j = 0; j < 4; ++j) { const int col = 4 * lane + 256 * j;
#pragma unroll
                for (int k = 0; k < 4; ++k) yy[u][j][k] = *(const int*)(Y + (size_t)p[u][k] * DM + col);
                raw[u][j] = *(const f32x2*)(X1 + (size_t)row * DM + col); gtv[u][j] = *(const f32x4*)(mod + (row / SEQ) * 6 * DM + 5 * DM + col); } }
#pragma unroll
        for (int u = 0; u < U; ++u) { const int row = r0 + u * ngw; if (row < NTOK) {
            f32x4 v[4]; float ss = 0.f;
#pragma unroll
            for (int j = 0; j < 4; ++j) { const int col = 4 * lane + 256 * j; f32x4 f = {0.f, 0.f, 0.f, 0.f};
#pragma unroll
                for (int k = 0; k < 4; ++k) { const f32x2 lo = __builtin_amdgcn_cvt_pk_f32_fp8(yy[u][j][k], false), hi = __builtin_amdgcn_cvt_pk_f32_fp8(yy[u][j][k], true);
                    f.x += wk[u][k] * lo.x; f.y += wk[u][k] * lo.y; f.z += wk[u][k] * hi.x; f.w += wk[u][k] * hi.y; }
                const f32x4 gt = gtv[u][j];
                const unsigned u0 = __float_as_uint(raw[u][j].x), u1 = __float_as_uint(raw[u][j].y);
                v[j] = (f32x4){__uint_as_float(u0 << 16), __uint_as_float(u0 & 0xffff0000u), __uint_as_float(u1 << 16), __uint_as_float(u1 & 0xffff0000u)} + gt * f; ss += v[j].x * v[j].x + v[j].y * v[j].y + v[j].z * v[j].z + v[j].w * v[j].w; }
            const float rstd = rsqrtf(wave_sum(ss) * (1.f / DM) + EPS);
#pragma unroll
            for (int j = 0; j < 4; ++j) { const int col = 4 * lane + 256 * j; *(f32x4*)(C.out + (size_t)row * DM + col) = v[j] * rstd * gfin[j]; }
        } }
    }
}

constexpr int N_PHASES = 11;
__global__ void __launch_bounds__(NWAVES * 64, 2) mega_fwd(Ctx Carg) {
    extern __shared__ __attribute__((aligned(16))) unsigned char lds_raw[];
    LAS unsigned char* lds = (LAS unsigned char*)lds_raw;
#define TZ() ({ int tz_ = threadIdx.x; asm volatile("" : "+v"(tz_)); tz_; })
#define WV(t) __builtin_amdgcn_readfirstlane((t) >> 6)
    { const int t0 = TZ(); for (int u = t0; u < (LDS_BYTES - LCTL_OFF) / 4; u += NWAVES * 64) ((LAS unsigned*)(lds + LCTL_OFF))[u] = 0u; }
    __syncthreads();
    const int ngw = gridDim.x * NWAVES;
    XcdBarrier bar = xcd_barrier_post((unsigned*)(Carg.ws + WS_CTL) + CW_BAR, (volatile LAS unsigned*)(lds + L_BARW));
    const int lo = Carg.ph_lo, hi = Carg.ph_hi;
#define C (*ctx_here())
#define IN(k) (lo <= (k) && (k) < hi)
#define SEAM(k) do { if (IN(k) && IN((k) + 1)) { xcd_barrier(bar); if (PROBE_DBL & 2048) xcd_barrier(bar); } } while (0)
    for (int rep_ = 0; rep_ < ((PROBE_DBL & 1) ? 2 : 1); ++rep_) if (IN(0)) { { const int t = TZ(); phase_weights(C, lds, blockIdx.x * NWAVES + WV(t), ngw, WV(t), t & 63); }
                 { const int t = TZ(); phase_mod_partials(C, blockIdx.x * NWAVES + WV(t), ngw, t & 63); }
                 { const int t = TZ(); phase_rope_misc(C, blockIdx.x * (NWAVES * 64) + t, gridDim.x * (NWAVES * 64)); } }
    SEAM(0);
    for (int rep_ = 0; rep_ < ((PROBE_DBL & 2) ? 2 : 1); ++rep_) if (IN(1)) { phase_norm1(C, lds); { const int t = TZ(); phase_quant_win(C, blockIdx.x * NWAVES + WV(t), ngw, t & 63); } }
    SEAM(1);
    for (int rep_ = 0; rep_ < ((PROBE_DBL & 4) ? 2 : 1); ++rep_) if (IN(2)) phase_proj(C, lds);
    SEAM(2);
    for (int rep_ = 0; rep_ < ((PROBE_DBL & 8) ? 2 : 1); ++rep_) if (IN(3)) phase_attn(C, lds_raw, lds, CW_QB + 256 * rep_, CW_QA + 256 * rep_, CW_QC + 256 * rep_);
    SEAM(3);
    for (int rep_ = 0; rep_ < ((PROBE_DBL & 16) ? 2 : 1); ++rep_) if (IN(4)) { const int t = TZ(); phase_combine(C, blockIdx.x * NWAVES + WV(t), ngw, t & 63); }
    SEAM(4);
    for (int rep_ = 0; rep_ < ((PROBE_DBL & 32) ? 2 : 1); ++rep_) if (IN(5)) phase_out(C, lds);
    SEAM(5);
    for (int rep_ = 0; rep_ < ((PROBE_DBL & 64) ? 2 : 1); ++rep_) if (IN(6)) phase_route(C, lds);
    SEAM(6);
    for (int rep_ = 0; rep_ < ((PROBE_DBL & 128) ? 2 : 1); ++rep_) if (IN(7)) phase_slots(C, lds);
    SEAM(7);
    int mx_X = 0, mx_Y = 0, mx_nx = 0; bool mixed = false;
    if (IN(8)) { if (!IN(7)) moe_tables(WSP(int, WS_HIST), lds);
        const int ntile = ((const LAS int*)(lds + L_POFF))[NE] >> 8;
        mixed = ((int)gridDim.x == 256) && IN(9) && ntile >= 256; mx_X = mixed ? 256 : ntile;
        if (mixed) { const int L = ntile - 256; mx_nx = (L + 3) >> 2; if (mx_nx > 8) mx_nx = 8; mx_Y = 192 + 8 * (8 - mx_nx); }
        phase_gate_up(C, lds, 0, mx_X, 0); }
    SEAM(8);
    if (IN(9)) { if (!IN(7)) moe_tables(WSP(int, WS_HIST), lds);
        const int ntile = ((const LAS int*)(lds + L_POFF))[NE] >> 8;
        if (mixed) { phase_gate_up(C, lds, mx_X, ntile, 0); phase_down(C, lds, 0, mx_Y, mx_nx); xcd_barrier(bar); phase_down(C, lds, mx_Y, ntile, 0); }
        else phase_down(C, lds, 0, ntile, 0); }
    SEAM(9);
    for (int rep_ = 0; rep_ < ((PROBE_DBL & 1024) ? 2 : 1); ++rep_) if (IN(10)) { const int t = TZ(); phase_final(C, blockIdx.x * NWAVES + WV(t), ngw, t & 63); }
#undef C
#undef IN
#undef SEAM
#undef TZ
#undef WV
}

#ifndef MK_N_LAUNCHES
#define MK_N_LAUNCHES 1
#endif
extern "C" void kernel_launch(void* const* d_in, const int* in_sizes, int n_in, void* d_out, int out_size, void* d_ws, size_t ws_size, hipStream_t stream) {
    static int grid = 0;
    if (grid == 0) {
        if (n_in != 22 || ws_size < WS_END) { grid = -1; return; }
        int dev = 0, cus = 0;
        if (hipGetDevice(&dev) != hipSuccess || hipDeviceGetAttribute(&cus, hipDeviceAttributeMultiprocessorCount, dev) != hipSuccess || cus <= 0) { grid = -1; return; }
        if (hipFuncSetAttribute((const void*)mega_fwd, hipFuncAttributeMaxDynamicSharedMemorySize, LDS_BYTES) != hipSuccess) { grid = -1; return; }
        int per_cu = 0;
        if (hipOccupancyMaxActiveBlocksPerMultiprocessor(&per_cu, (const void*)mega_fwd, NWAVES * 64, LDS_BYTES) != hipSuccess || per_cu < 1) { (void)hipGetLastError(); }
        grid = cus;
    }
    if (grid < 0) return;
    (void)hipMemsetAsync((char*)d_ws + WS_CTL, 0, CTL_ZERO_BYTES, stream);
    Ctx C{};
    C.x = (const float*)d_in[0]; C.c = (const float*)d_in[1]; C.positions = (const int*)d_in[2]; C.w_ada = (const float*)d_in[3]; C.b_ada = (const float*)d_in[4];
    C.g_mix = (const float*)d_in[5]; C.w_in = (const float*)d_in[6]; C.rel_bias = (const float*)d_in[7]; C.lq1 = (const float*)d_in[8]; C.lk1 = (const float*)d_in[9];
    C.lq2 = (const float*)d_in[10]; C.lk2 = (const float*)d_in[11]; C.g_subln = (const float*)d_in[12]; C.w_out = (const float*)d_in[13]; C.g_ffn = (const float*)d_in[14];
    C.w_router = (const float*)d_in[15]; C.b_router = (const float*)d_in[16]; C.w_gate_up = (const float*)d_in[17]; C.b_gate_up = (const float*)d_in[18];
    C.w_down = (const float*)d_in[19]; C.b_down = (const float*)d_in[20]; C.g_final = (const float*)d_in[21];
    C.out = (float*)d_out; C.ws = (unsigned char*)d_ws;
    if (MK_N_LAUNCHES == 1) { C.ph_lo = 0; C.ph_hi = N_PHASES; hipLaunchKernelGGL(mega_fwd, dim3(grid), dim3(NWAVES * 64), LDS_BYTES, stream, C); }
    else for (int p = 0; p < N_PHASES; ++p) { C.ph_lo = p; C.ph_hi = p + 1; hipLaunchKernelGGL(mega_fwd, dim3(grid), dim3(NWAVES * 64), LDS_BYTES, stream, C); }
}
```
